# Optimizing an MI355X kernel written in HIP

```python
import math
import jax, jax.numpy as jnp
from jax import lax
import numpy as np

D_MODEL = 1024
BATCH = 2
SEQ = 8192
DEPTH = 4
DEC_BATCH = 128
DEC_SEQ = 1
PAST_LEN = 8192
PAGE_SIZE = 128

D_MIX = D_MODEL
CONV_DIM = D_MIX // 4
POOL_DIM = D_MIX // 4
ATTN_DIM = D_MIX - CONV_DIM - POOL_DIM
HEAD_DIM = 64
CONV_WIDTH = 3
POOL_WINDOWS = (2, 4, 8, 16)
N_POOL_GROUPS = 4
POOL_GROUP_DIM = POOL_DIM // N_POOL_GROUPS
MAX_POOL = 16
N_HEADS = ATTN_DIM // HEAD_DIM
N_KV_HEADS = 2
GQA_GROUP = N_HEADS // N_KV_HEADS
WINDOW = 128
D_FF = 2816
KV_DIM = N_KV_HEADS * HEAD_DIM
IN_SPLITS = (CONV_DIM, CONV_DIM, CONV_DIM, POOL_DIM, ATTN_DIM, KV_DIM, KV_DIM)
D_IN = CONV_DIM * 3 + POOL_DIM + ATTN_DIM + 2 * KV_DIM
N_MOD = 9
ALPHA = (2.0 * DEPTH) ** 0.25
BETA = (8.0 * DEPTH) ** -0.25
LN_EPS = 1e-5
RMS_EPS = 1e-6
NEG_INF = -1e30

kernel_name = "hymba_conv_pool_swa_macaron_decode"


def layer_norm(x, g, b):
    x32 = x.astype(jnp.float32)
    mu = jnp.mean(x32, axis=-1, keepdims=True)
    var = jnp.mean(jnp.square(x32 - mu), axis=-1, keepdims=True)
    return ((x32 - mu) * lax.rsqrt(var + LN_EPS) * g.astype(jnp.float32) + b.astype(jnp.float32)).astype(x.dtype)


def rms_norm(x, g):
    x32 = x.astype(jnp.float32)
    y = x32 * lax.rsqrt(jnp.mean(x32 * x32, axis=-1, keepdims=True) + RMS_EPS)
    return (y * g.astype(jnp.float32)).astype(x.dtype)


def swiglu(h, w_gate, w_up, w_down):
    return (jax.nn.silu(h @ w_gate) * (h @ w_up)) @ w_down


def short_conv(ext, w, t):
    y = w[0] * ext[:, :t]
    for k in range(1, CONV_WIDTH):
        y = y + w[k] * ext[:, k:k + t]
    return y


def multiscale_pool(ext, start_pos, t, w_pool, pool_scale):
    p = MAX_POOL - 1
    x32 = ext.astype(jnp.float32)
    cs = jnp.concatenate([jnp.zeros_like(x32[:, :1]), jnp.cumsum(x32, axis=1)], axis=1)
    pos = start_pos + jnp.arange(t)
    outs = []
    for g, w in enumerate(POOL_WINDOWS):
        lo, hi = g * POOL_GROUP_DIM, (g + 1) * POOL_GROUP_DIM
        win_sum = cs[:, p + 1:p + 1 + t, lo:hi] - cs[:, p + 1 - w:p + 1 - w + t, lo:hi]
        count = jnp.minimum(pos + 1, w).astype(jnp.float32)[None, :, None]
        pooled = (win_sum / count - x32[:, p:, lo:hi]).astype(ext.dtype)
        outs.append(jnp.einsum('btc,cd->btd', pooled, w_pool[g]))
    return jnp.concatenate(outs, axis=-1) * pool_scale


def sink_softmax(s, mask, sinks):
    sink = sinks.astype(jnp.float32).reshape(N_KV_HEADS, GQA_GROUP, 1, 1)
    s = jnp.where(mask, s, NEG_INF)
    m = jnp.maximum(jnp.max(s, axis=-1, keepdims=True), sink)
    p = jnp.exp(s - m)
    return p / (jnp.sum(p, axis=-1, keepdims=True) + jnp.exp(sink - m))


def swa_prompt(q, k, v, sinks):
    b, s = q.shape[0], q.shape[1]
    nb = s // WINDOW
    qb = q.reshape(b, nb, WINDOW, N_KV_HEADS, GQA_GROUP, HEAD_DIM)
    kb = k.reshape(b, nb, WINDOW, N_KV_HEADS, HEAD_DIM)
    vb = v.reshape(b, nb, WINDOW, N_KV_HEADS, HEAD_DIM)
    kk = jnp.concatenate([jnp.concatenate([jnp.zeros_like(kb[:, :1]), kb[:, :-1]], axis=1), kb], axis=2)
    vv = jnp.concatenate([jnp.concatenate([jnp.zeros_like(vb[:, :1]), vb[:, :-1]], axis=1), vb], axis=2)
    scores = jnp.einsum('bnqhgd,bnkhd->bnhgqk', qb, kk).astype(jnp.float32) * (HEAD_DIM ** -0.5)
    blk = jnp.arange(nb)[:, None, None]
    qpos = blk * WINDOW + jnp.arange(WINDOW)[None, :, None]
    kpos = (blk - 1) * WINDOW + jnp.arange(2 * WINDOW)[None, None, :]
    mask = (kpos <= qpos) & (qpos - kpos < WINDOW) & (kpos >= 0)
    probs = sink_softmax(scores, mask[None, :, None, None], sinks)
    out = jnp.einsum('bnhgqk,bnkhd->bnqhgd', probs.astype(vv.dtype), vv)
    return out.reshape(b, s, ATTN_DIM)


def swa_sample(q, k_ext, v_ext, sinks):
    b, t = q.shape[0], q.shape[1]
    L = k_ext.shape[1] - t
    scores = jnp.einsum('bqhgd,bkhd->bhgqk', q, k_ext).astype(jnp.float32) * (HEAD_DIM ** -0.5)
    qpos = jnp.arange(t)[:, None]
    kpos = jnp.arange(L + t)[None, :] - L
    mask = (kpos <= qpos) & (qpos - kpos < WINDOW)
    probs = sink_softmax(scores, mask, sinks)
    out = jnp.einsum('bhgqk,bkhd->bqhgd', probs.astype(v_ext.dtype), v_ext)
    return out.reshape(b, t, ATTN_DIM)


def token_mixer(h, w_in, conv_w, pool_w, pool_scale, sinks, mix_g, w_out,
                conv_prefix, pool_prefix, k_prefix, v_prefix, start_pos):
    b, t, _ = h.shape
    proj = h @ w_in
    split_idx = np.cumsum(IN_SPLITS)[:-1].tolist()
    gb, gc, xin, u, q, k, v = jnp.split(proj, split_idx, axis=-1)
    cv = gc * xin
    conv_ext = jnp.concatenate([conv_prefix.astype(cv.dtype), cv], axis=1)
    y_conv = gb * short_conv(conv_ext, conv_w, t)
    new_conv = conv_ext[:, -(CONV_WIDTH - 1):]
    pool_ext = jnp.concatenate([pool_prefix.astype(u.dtype), u], axis=1)
    y_pool = multiscale_pool(pool_ext, start_pos, t, pool_w, pool_scale)
    new_pool = pool_ext[:, -(MAX_POOL - 1):]
    q = q.reshape(b, t, N_KV_HEADS, GQA_GROUP, HEAD_DIM)
    k = k.reshape(b, t, N_KV_HEADS, HEAD_DIM)
    v = v.reshape(b, t, N_KV_HEADS, HEAD_DIM)
    if k_prefix is None:
        y_attn = swa_prompt(q, k, v, sinks)
        new_k, new_v = k[:, -WINDOW:], v[:, -WINDOW:]
    else:
        buf = k_prefix.shape[1]
        k_ext = jnp.concatenate([k_prefix.astype(k.dtype), k], axis=1)
        v_ext = jnp.concatenate([v_prefix.astype(v.dtype), v], axis=1)
        y_attn = swa_sample(q, k_ext, v_ext, sinks)
        new_k, new_v = k_ext[:, -buf:], v_ext[:, -buf:]
    y = jnp.concatenate([
        rms_norm(y_conv, mix_g[:CONV_DIM]),
        rms_norm(y_pool, mix_g[CONV_DIM:CONV_DIM + POOL_DIM]),
        rms_norm(y_attn, mix_g[CONV_DIM + POOL_DIM:]),
    ], axis=-1)
    return y @ w_out, new_conv, new_pool, new_k, new_v


def run_trunk(x, c, conv_bufs, pool_bufs, k_bufs, v_bufs, start_pos,
              ln_g, ln_b, w_ada, b_ada, ffn1_gate, ffn1_up, ffn1_down,
              w_in, conv_w, pool_w, pool_scale, attn_sinks, mix_norm_g, w_out,
              ffn2_gate, ffn2_up, ffn2_down):
    b = x.shape[0]
    convs, pools, ks, vs = [], [], [], []
    for l in range(DEPTH):
        m = (jax.nn.silu(c) @ w_ada[l] + b_ada[l]).reshape(b, 1, N_MOD, D_MODEL)
        h = x * (1 + m[:, :, 1]) + m[:, :, 0]
        sub = 0.5 * swiglu(h, ffn1_gate[l], ffn1_up[l], ffn1_down[l])
        x = layer_norm(ALPHA * x + m[:, :, 2] * sub, ln_g[l, 0], ln_b[l, 0])
        h = x * (1 + m[:, :, 4]) + m[:, :, 3]
        if conv_bufs is None:
            conv_pre = jnp.zeros((b, CONV_WIDTH - 1, CONV_DIM), x.dtype)
            pool_pre = jnp.zeros((b, MAX_POOL - 1, POOL_DIM), x.dtype)
            k_pre, v_pre = None, None
        else:
            conv_pre, pool_pre, k_pre, v_pre = conv_bufs[l], pool_bufs[l], k_bufs[l], v_bufs[l]
        sub, nc, npool, nk, nv = token_mixer(h, w_in[l], conv_w[l], pool_w[l], pool_scale[l],
                                             attn_sinks[l], mix_norm_g[l], w_out[l],
                                             conv_pre, pool_pre, k_pre, v_pre, start_pos)
        x = layer_norm(ALPHA * x + m[:, :, 5] * sub, ln_g[l, 1], ln_b[l, 1])
        h = x * (1 + m[:, :, 7]) + m[:, :, 6]
        sub = 0.5 * swiglu(h, ffn2_gate[l], ffn2_up[l], ffn2_down[l])
        x = layer_norm(ALPHA * x + m[:, :, 8] * sub, ln_g[l, 2], ln_b[l, 2])
        convs.append(nc)
        pools.append(npool)
        ks.append(nk)
        vs.append(nv)
    return x, jnp.stack(convs), jnp.stack(pools), jnp.stack(ks), jnp.stack(vs)


def setup_inputs(seed: int = 0) -> dict:
    key = jax.random.key(seed)
    ks = jax.random.split(key, 32)
    f32 = jnp.float32
    win_buf = min(WINDOW, PAST_LEN)

    def nrm(k, shape, scale):
        return jax.random.normal(k, shape, f32) * scale

    return {
        'x_prompt': nrm(ks[0], (BATCH, SEQ, D_MODEL), 1.0),
        'x_sample': nrm(ks[1], (DEC_BATCH, DEC_SEQ, D_MODEL), 1.0),
        'state_conv': nrm(ks[2], (DEPTH, DEC_BATCH, CONV_WIDTH - 1, CONV_DIM), 1.0),
        'state_pool': nrm(ks[3], (DEPTH, DEC_BATCH, MAX_POOL - 1, POOL_DIM), 1.0),
        'cache_k_win': nrm(ks[4], (DEPTH, DEC_BATCH, win_buf, N_KV_HEADS, HEAD_DIM), 1.0),
        'cache_v_win': nrm(ks[5], (DEPTH, DEC_BATCH, win_buf, N_KV_HEADS, HEAD_DIM), 1.0),
        'c_prompt': nrm(ks[6], (BATCH, D_MODEL), 1.0),
        'c_sample': nrm(ks[7], (DEC_BATCH, D_MODEL), 1.0),
        'ln_g': 1.0 + nrm(ks[8], (DEPTH, 3, D_MODEL), 0.02),
        'ln_b': nrm(ks[9], (DEPTH, 3, D_MODEL), 0.02),
        'w_ada': nrm(ks[10], (DEPTH, D_MODEL, N_MOD * D_MODEL), 0.5 * D_MODEL ** -0.5),
        'b_ada': nrm(ks[11], (DEPTH, N_MOD * D_MODEL), 0.02),
        'ffn1_gate': nrm(ks[12], (DEPTH, D_MODEL, D_FF), D_MODEL ** -0.5),
        'ffn1_up': nrm(ks[13], (DEPTH, D_MODEL, D_FF), D_MODEL ** -0.5),
        'ffn1_down': nrm(ks[14], (DEPTH, D_FF, D_MODEL), BETA * D_FF ** -0.5),
        'w_in': nrm(ks[15], (DEPTH, D_MODEL, D_IN), D_MODEL ** -0.5),
        'conv_w': nrm(ks[16], (DEPTH, CONV_WIDTH, CONV_DIM), CONV_WIDTH ** -0.5),
        'pool_w': nrm(ks[17], (DEPTH, N_POOL_GROUPS, POOL_GROUP_DIM, POOL_GROUP_DIM), POOL_GROUP_DIM ** -0.5),
        'pool_scale': 1.0 + nrm(ks[18], (DEPTH, POOL_DIM), 0.1),
        'attn_sinks': nrm(ks[19], (DEPTH, N_HEADS), 1.0),
        'mix_norm_g': 1.0 + nrm(ks[20], (DEPTH, D_MIX), 0.1),
        'w_out': nrm(ks[21], (DEPTH, D_MIX, D_MODEL), BETA * D_MIX ** -0.5),
        'ffn2_gate': nrm(ks[22], (DEPTH, D_MODEL, D_FF), D_MODEL ** -0.5),
        'ffn2_up': nrm(ks[23], (DEPTH, D_MODEL, D_FF), D_MODEL ** -0.5),
        'ffn2_down': nrm(ks[24], (DEPTH, D_FF, D_MODEL), BETA * D_FF ** -0.5),
    }


def reference(x_prompt, x_sample, state_conv, state_pool, cache_k_win, cache_v_win,
              c_prompt, c_sample, ln_g, ln_b, w_ada, b_ada, ffn1_gate, ffn1_up, ffn1_down,
              w_in, conv_w, pool_w, pool_scale, attn_sinks, mix_norm_g, w_out,
              ffn2_gate, ffn2_up, ffn2_down):
    y_prompt, p_conv, p_pool, p_k, p_v = run_trunk(
        x_prompt, c_prompt, None, None, None, None, 0,
        ln_g, ln_b, w_ada, b_ada, ffn1_gate, ffn1_up, ffn1_down,
        w_in, conv_w, pool_w, pool_scale, attn_sinks, mix_norm_g, w_out,
        ffn2_gate, ffn2_up, ffn2_down)
    y_sample, s_conv, s_pool, s_k, s_v = run_trunk(
        x_sample, c_sample, state_conv, state_pool, cache_k_win, cache_v_win, PAST_LEN,
        ln_g, ln_b, w_ada, b_ada, ffn1_gate, ffn1_up, ffn1_down,
        w_in, conv_w, pool_w, pool_scale, attn_sinks, mix_norm_g, w_out,
        ffn2_gate, ffn2_up, ffn2_down)
    return (y_prompt, y_sample, p_conv, p_pool, p_k, p_v, s_conv, s_pool, s_k, s_v)
```

```cpp
#include <hip/hip_runtime.h>
#include <hip/hip_cooperative_groups.h>
#include <cstdio>
#include <cstdint>
namespace cg = cooperative_groups;
namespace pg8 {
#define PG8_LAS __attribute__((address_space(3)))
typedef unsigned short bf16_t;
typedef short bf16x8 __attribute__((ext_vector_type(8)));
typedef float f32x4 __attribute__((ext_vector_type(4)));
typedef unsigned u32x4 __attribute__((ext_vector_type(4)));
constexpr int BM = 256, BK = 64, HALF = 128, HTB = HALF * BK * 2  , STAGE_BYTES = 8 * HTB, NXCD = 8, WGM = 8;

__host__ __device__ __forceinline__ int lds_byte(int r, int c) { const int st = (r >> 4) * 2 + (c >> 5), rr = r & 15, cc = c & 31, ob = rr * 64 + cc * 2; return st * 1024 + (ob ^ (((ob >> 9) & 1) << 5)); }
__host__ __device__ __forceinline__ void stage_rc(int b, int& R, int& C) { const int st = b / 1024, sb = b % 1024, swz = sb ^ (((sb >> 9) & 1) << 5); R = (st >> 1) * 16 + swz / 64; C = (st & 1) * 32 + (swz % 64) / 2; }
__host__ __device__ __forceinline__ int perm32(int rho) { const int n = rho >> 4, i = rho & 15; return 8 * (i >> 2) + 4 * n + (i & 3); }

struct Unit { int pm, pn; };
struct Gemm { const bf16_t* A; const bf16_t* Bt; int M, N, K; };

struct StaticOrder {
    int nM, nN, nwg, G, c;
    __host__ __device__ void init(int M, int N, int G_, int c_) { nM = M / BM; nN = N / BM; nwg = nM * nN; G = G_; c = c_; }
    __host__ __device__ bool next(int i, Unit& u) const {
        const long L = (long)i * G + c; if (L >= nwg) return false;
        int wgid = (int)L; { const int q = nwg / NXCD, r = nwg % NXCD, xcd = wgid % NXCD, off = wgid / NXCD; wgid = (xcd < r ? xcd * (q + 1) : r * (q + 1) + (xcd - r) * q) + off; }
        const int nig = WGM * nN, gid = wgid / nig, fm = gid * WGM, gsz = (nM - fm) < WGM ? (nM - fm) : WGM;
        u.pm = fm + ((wgid % nig) % gsz); u.pn = (wgid % nig) / gsz; return true;
    }
    __device__ __forceinline__ void a_ready(const Unit&) const {}
    __device__ __forceinline__ void done(const Unit&) const {}
};

__device__ __forceinline__ unsigned cvt_pk_bf16(float lo, float hi) { unsigned r; asm volatile("v_cvt_pk_bf16_f32 %0, %1, %2" : "=v"(r) : "v"(lo), "v"(hi)); return r; }
typedef float f32x2 __attribute__((ext_vector_type(2)));
__device__ __forceinline__ f32x2 gelu_pk(f32x2 v) {
    const f32x2 av = __builtin_elementwise_abs(v), d = av * 0.2316418882f + 1.0f;
    f32x2 t; t.x = __builtin_amdgcn_rcpf(d.x); t.y = __builtin_amdgcn_rcpf(d.y);
    f32x2 q = t * 0.5307027145f + (-0.7265760135f); q = q * t + 0.7107068705f; q = q * t + (-0.142248368f); q = q * t + 0.127414796f; q = q * t;
    const f32x2 s = (v * v) * (-0.72134752044f);
    f32x2 e; e.x = __builtin_amdgcn_exp2f(s.x); e.y = __builtin_amdgcn_exp2f(s.y);
    const f32x2 m = v * (q * e), r = v - m;
    f32x2 o; o.x = v.x < 0.f ? m.x : r.x; o.y = v.y < 0.f ? m.y : r.y; return o;
}

template <int ACT  > struct EpiBf16 {
    static constexpr bool PERM = true, AFTER_DRAIN = false; static_assert(ACT == 0 || ACT == 1, "EpiBf16: ACT is 0 (none) or 1 (gelu_pk)");
    bf16_t* O; int ldc; const float* bias; int split_cols; size_t split_stride; float scale0;
    __device__ __forceinline__ void operator()(const f32x4 (&acc)[2][2][4][2], const Unit& u, int wr, int wc, int fr, int fq) const {
        const int row0 = u.pm * BM + wr * 64 + fr; int colt = u.pn * BM; bf16_t* base = O;
        float sc = 1.f; if (split_cols) { const int t = colt / split_cols; base += (size_t)t * split_stride; colt -= t * split_cols; if (t == 0) sc = scale0; }
        const int col0 = colt + wc * 32 + 8 * fq, bcol0 = u.pn * BM + wc * 32 + 8 * fq;
        f32x4 bv[2][2];
#pragma unroll
        for (int bj = 0; bj < 2; ++bj)
#pragma unroll
            for (int n = 0; n < 2; ++n) bv[bj][n] = bias ? *(const f32x4*)(bias + bcol0 + bj * HALF + 4 * n) : (f32x4){0.f, 0.f, 0.f, 0.f};
#pragma unroll
        for (int ai = 0; ai < 2; ++ai)
#pragma unroll
            for (int m = 0; m < 4; ++m) { bf16_t* rowp = base + (size_t)(row0 + ai * HALF + m * 16) * ldc + col0;
#pragma unroll
                for (int bj = 0; bj < 2; ++bj) { f32x4 v0 = acc[ai][bj][m][0] + bv[bj][0], v1 = acc[ai][bj][m][1] + bv[bj][1];
                    if (ACT == 1) { f32x2 a = gelu_pk((f32x2){v0[0], v0[1]}), b = gelu_pk((f32x2){v0[2], v0[3]}), c = gelu_pk((f32x2){v1[0], v1[1]}), d = gelu_pk((f32x2){v1[2], v1[3]});
                        v0 = (f32x4){a.x, a.y, b.x, b.y}; v1 = (f32x4){c.x, c.y, d.x, d.y}; }
                    v0 = v0 * sc; v1 = v1 * sc; u32x4 w; w.x = cvt_pk_bf16(v0[0], v0[1]); w.y = cvt_pk_bf16(v0[2], v0[3]); w.z = cvt_pk_bf16(v1[0], v1[1]); w.w = cvt_pk_bf16(v1[2], v1[3]);
                    *(u32x4*)(rowp + bj * HALF) = w; } }
    }
};

struct PanelStats {
    unsigned* xbuf;
    unsigned* cnt;
    unsigned* tmo;
    int ntn; float eps;
    unsigned code;
    __device__ __forceinline__ bool run(const f32x4 (&v)[2][2][4][2], const Unit& u, int wr, int wc, int fr, int fq, PG8_LAS unsigned char* lds, int wid, int lane) const {
        typedef float f32x2v __attribute__((ext_vector_type(2)));
        PG8_LAS f32x2v* P = (PG8_LAS f32x2v*)lds;
        PG8_LAS f32x2v* S = (PG8_LAS f32x2v*)(lds + 8192);
        PG8_LAS unsigned* flag = (PG8_LAS unsigned*)(lds + 8192 + 2048);
#pragma unroll
        for (int ai = 0; ai < 2; ++ai)
#pragma unroll
            for (int m = 0; m < 4; ++m) {
                float s = 0.f;
#pragma unroll
                for (int bj = 0; bj < 2; ++bj)
#pragma unroll
                    for (int n = 0; n < 2; ++n) { const f32x4 x = v[ai][bj][m][n]; s += (x[0] + x[1]) + (x[2] + x[3]); }
                s += __shfl_xor(s, 16); s += __shfl_xor(s, 32);
                const float mw = s * (1.0f / 64.0f); float q = 0.f;
#pragma unroll
                for (int bj = 0; bj < 2; ++bj)
#pragma unroll
                    for (int n = 0; n < 2; ++n) { const f32x4 d = v[ai][bj][m][n] - mw; q += (d[0] * d[0] + d[1] * d[1]) + (d[2] * d[2] + d[3] * d[3]); }
                q += __shfl_xor(q, 16); q += __shfl_xor(q, 32);
                if (fq == 0) P[(ai * HALF + wr * 64 + m * 16 + fr) * 4 + wc] = (f32x2v){mw, q};
            }
        asm volatile("s_waitcnt lgkmcnt(0)" ::: "memory"); __builtin_amdgcn_s_barrier(); asm volatile("" ::: "memory");
#if defined(BROKEN_EXCHANGE_NO_WAIT)
#warning BROKEN CONTROL BUILD: the row-statistics exchange does not wait; results are wrong by design
        if (blockIdx.x >= 64) { const long long t0_ = clock64(); while (clock64() - t0_ < 60000) __builtin_amdgcn_s_sleep(8); }
#endif
        const int row = wid * 32 + (lane & 31);
        if (lane < 32) {
            const f32x2v a = P[row * 4 + 0], b = P[row * 4 + 1], c = P[row * 4 + 2], d = P[row * 4 + 3];
            const float mt = (a.x + b.x + c.x + d.x) * 0.25f;
            const float da = a.x - mt, db = b.x - mt, dc = c.x - mt, dd = d.x - mt;
            const float m2 = (a.y + b.y) + (c.y + d.y) + 64.0f * ((da * da + db * db) + (dc * dc + dd * dd));
            unsigned long long* slot = (unsigned long long*)xbuf + ((size_t)(u.pm * BM + row) * 4 + u.pn);
            __hip_atomic_store(slot, ((unsigned long long)__float_as_uint(m2) << 32) | __float_as_uint(mt), __ATOMIC_RELAXED, __HIP_MEMORY_SCOPE_AGENT);
        }
        asm volatile("s_waitcnt vmcnt(0)" ::: "memory");
        if (lane == 0) __hip_atomic_fetch_add(cnt + 64 * u.pm, 1u, __ATOMIC_RELAXED, __HIP_MEMORY_SCOPE_AGENT);
        if (wid == 0) {
            bool dead = false; const unsigned long long t0 = __builtin_amdgcn_s_memrealtime(); const unsigned want = 8u * (unsigned)ntn;
            for (;;) {
#if defined(BROKEN_EXCHANGE_NO_WAIT)
                break;
#endif
                if ((unsigned)__builtin_amdgcn_readfirstlane(__hip_atomic_load(cnt + 64 * u.pm, __ATOMIC_RELAXED, __HIP_MEMORY_SCOPE_AGENT)) >= want) break;
                if (__builtin_amdgcn_s_memrealtime() - t0 > 2000000ull) {
                    if (lane == 0) { unsigned expect = 0u; __hip_atomic_compare_exchange_strong(tmo + 1, &expect, code | (unsigned)(u.pm & 0xff), __ATOMIC_RELAXED, __ATOMIC_RELAXED, __HIP_MEMORY_SCOPE_AGENT);
                                     __hip_atomic_store(tmo, 1u, __ATOMIC_RELAXED, __HIP_MEMORY_SCOPE_AGENT); }
                    dead = true; break; }
                __builtin_amdgcn_s_sleep(2);
            }
            __builtin_amdgcn_fence(__ATOMIC_ACQUIRE, "agent");
            if (lane == 0) flag[0] = dead ? 1u : 0u;
        }
        asm volatile("s_waitcnt vmcnt(0) lgkmcnt(0)" ::: "memory"); __builtin_amdgcn_s_barrier(); asm volatile("" ::: "memory");
        const bool bad = flag[0] != 0u;
        if (lane < 32) {
            const unsigned long long* slot = (const unsigned long long*)xbuf + (size_t)(u.pm * BM + row) * 4; float mt[4], m2[4]; float ms = 0.f;
#pragma unroll
            for (int t = 0; t < 4; ++t) { if (t < ntn) { const unsigned long long w = __hip_atomic_load(slot + t, __ATOMIC_RELAXED, __HIP_MEMORY_SCOPE_AGENT); mt[t] = __uint_as_float((unsigned)w); m2[t] = __uint_as_float((unsigned)(w >> 32)); } else { mt[t] = 0.f; m2[t] = 0.f; } ms += mt[t]; }
            const float mean = ms / (float)ntn; float q = 0.f;
#pragma unroll
            for (int t = 0; t < 4; ++t) if (t < ntn) { const float dm = mt[t] - mean; q += m2[t] + 256.0f * dm * dm; }
            S[row] = (f32x2v){mean, 1.0f / sqrtf(q / (256.0f * (float)ntn) + eps)};
        }
        asm volatile("s_waitcnt lgkmcnt(0)" ::: "memory"); __builtin_amdgcn_s_barrier(); asm volatile("" ::: "memory");
        return bad;
    }
};
struct EpiLnRes {
    static constexpr bool PERM = false, AFTER_DRAIN = true;
    const float* base; float* out; int ldc; const float* bias; PanelStats st; unsigned poison;
    __device__ __forceinline__ void fused(f32x4 (&acc)[2][2][4][2], const Unit& u, int wr, int wc, int fr, int fq, PG8_LAS unsigned char* lds, int wid, int lane) const {
        typedef float f32x2v __attribute__((ext_vector_type(2)));
        const PG8_LAS f32x2v* S = (const PG8_LAS f32x2v*)(lds + 8192);
        const int col0 = u.pn * BM + wc * 32 + 4 * fq;
#pragma unroll
        for (int bj = 0; bj < 2; ++bj)
#pragma unroll
            for (int n = 0; n < 2; ++n) { const f32x4 bv = bias ? *(const f32x4*)(bias + col0 + bj * HALF + n * 16) : (f32x4){0.f, 0.f, 0.f, 0.f};
#pragma unroll
                for (int ai = 0; ai < 2; ++ai)
#pragma unroll
                    for (int m = 0; m < 4; ++m) acc[ai][bj][m][n] += bv; }
        f32x4 pre[4][2][2];
#pragma unroll
        for (int m = 0; m < 4; ++m) { const size_t off = (size_t)(u.pm * BM + wr * 64 + m * 16 + fr) * ldc + col0;
#pragma unroll
            for (int bj = 0; bj < 2; ++bj)
#pragma unroll
                for (int n = 0; n < 2; ++n) pre[m][bj][n] = *(const f32x4*)(base + off + bj * HALF + n * 16); }
        const bool bad = st.run(acc, u, wr, wc, fr, fq, lds, wid, lane) || poison != 0u;
        const float qnan = __builtin_nanf("");
#pragma unroll
        for (int ai = 0; ai < 2; ++ai)
#pragma unroll
            for (int m = 0; m < 4; ++m) { const int r = ai * HALF + wr * 64 + m * 16 + fr; const f32x2v sr = S[r]; const size_t off = (size_t)(u.pm * BM + r) * ldc + col0;
#pragma unroll
                for (int bj = 0; bj < 2; ++bj)
#pragma unroll
                    for (int n = 0; n < 2; ++n) { const f32x4 bs = ai == 0 ? pre[m][bj][n] : *(const f32x4*)(base + off + bj * HALF + n * 16); f32x4 o = bs + (acc[ai][bj][m][n] - sr.x) * sr.y;
                        if (bad) o = (f32x4){qnan, qnan, qnan, qnan}; *(f32x4*)(out + off + bj * HALF + n * 16) = o; }
                if (m & 1) asm volatile("" ::: "memory"); }
    }
};
struct EpiLnResLn {
    static constexpr bool PERM = false, AFTER_DRAIN = true;
    const float* base; float* out; bf16_t* xn; int ldc; const float* bias; PanelStats st1, st2; unsigned poison;
    __device__ __forceinline__ void fused(f32x4 (&acc)[2][2][4][2], const Unit& u, int wr, int wc, int fr, int fq, PG8_LAS unsigned char* lds, int wid, int lane) const {
        typedef float f32x2v __attribute__((ext_vector_type(2))); typedef unsigned u32x2v __attribute__((ext_vector_type(2)));
        const PG8_LAS f32x2v* S = (const PG8_LAS f32x2v*)(lds + 8192);
        const int col0 = u.pn * BM + wc * 32 + 4 * fq;
#pragma unroll
        for (int bj = 0; bj < 2; ++bj)
#pragma unroll
            for (int n = 0; n < 2; ++n) { const f32x4 bv = bias ? *(const f32x4*)(bias + col0 + bj * HALF + n * 16) : (f32x4){0.f, 0.f, 0.f, 0.f};
#pragma unroll
                for (int ai = 0; ai < 2; ++ai)
#pragma unroll
                    for (int m = 0; m < 4; ++m) acc[ai][bj][m][n] += bv; }
        bool bad = st1.run(acc, u, wr, wc, fr, fq, lds, wid, lane) || poison != 0u;
        const float qnan = __builtin_nanf("");
#pragma unroll
        for (int ai = 0; ai < 2; ++ai)
#pragma unroll
            for (int m = 0; m < 4; ++m) { const int r = ai * HALF + wr * 64 + m * 16 + fr; const f32x2v sr = S[r]; const size_t off = (size_t)(u.pm * BM + r) * ldc + col0;
#pragma unroll
                for (int bj = 0; bj < 2; ++bj)
#pragma unroll
                    for (int n = 0; n < 2; ++n) { const f32x4 bs = *(const f32x4*)(base + off + bj * HALF + n * 16); acc[ai][bj][m][n] = bs + (acc[ai][bj][m][n] - sr.x) * sr.y; }
                asm volatile("" : "+v"(acc[ai][0][m][0]), "+v"(acc[ai][0][m][1]), "+v"(acc[ai][1][m][0]), "+v"(acc[ai][1][m][1]));
                if (m & 1) asm volatile("" ::: "memory"); }
        const bool bad1 = bad;
        bad = st2.run(acc, u, wr, wc, fr, fq, lds, wid, lane) || bad;
#pragma unroll
        for (int ai = 0; ai < 2; ++ai)
#pragma unroll
            for (int m = 0; m < 4; ++m) { const int r = ai * HALF + wr * 64 + m * 16 + fr; const f32x2v sr = S[r]; const size_t off = (size_t)(u.pm * BM + r) * ldc + col0;
#pragma unroll
                for (int bj = 0; bj < 2; ++bj)
#pragma unroll
                    for (int n = 0; n < 2; ++n) { const f32x4 x1 = acc[ai][bj][m][n]; *(f32x4*)(out + off + bj * HALF + n * 16) = bad1 ? (f32x4){qnan, qnan, qnan, qnan} : x1;
                        const f32x4 o = (x1 - sr.x) * sr.y; u32x2v w; w.x = cvt_pk_bf16(o[0], o[1]); w.y = cvt_pk_bf16(o[2], o[3]);
                        if (bad) { w.x = 0x7fc07fc0u; w.y = 0x7fc07fc0u; } *(u32x2v*)(xn + off + bj * HALF + n * 16) = w; }
                asm volatile("" ::: "memory"); }
    }
};

template <class Epi, class Sched, bool ALIGN_EPI = false, bool SP2 = false>
__device__ __forceinline__ void gemm_phase(PG8_LAS unsigned char* lds, const Gemm g, const Sched& S, const Epi& E) {
    int tid = threadIdx.x; asm volatile("" : "+v"(tid));
    const int wid = __builtin_amdgcn_readfirstlane(tid >> 6), lane = tid & 63, wr = wid >> 2, wc = wid & 3, fr = lane & 15, fq = lane >> 4;
    const int K = g.K, nt = K / BK;
    unsigned voffA[2], voffB[2];
#pragma unroll
    for (int i = 0; i < 2; ++i) { int R, C; stage_rc(tid * 16 + i * 8192, R, C); const int Rb = Epi::PERM ? ((R & ~31) + perm32(R & 31)) : R;
        voffA[i] = (unsigned)(R * K + C) * 2u; voffB[i] = (unsigned)(Rb * K + C) * 2u; }
    const size_t kstep = (size_t)(BK * 2);
    const size_t hstep = (size_t)HALF * K * 2;
    const size_t tstep = 2 * hstep;
    const unsigned ldsw = (unsigned)wid * 1024u;
    const int aoff = lds_byte(wr * 64 + fr, fq * 8), boff = lds_byte(wc * 32 + fr, fq * 8);
#define PG8_SA(b, h) (((b) * 2 + (h)) * HTB)
#define PG8_SB(b, h) ((4 + (b) * 2 + (h)) * HTB)
#define PG8_STAGE(bufoff, gbase, voff) do { _Pragma("unroll") for (int _i = 0; _i < 2; ++_i) \
        __builtin_amdgcn_global_load_lds((const unsigned*)((const char*)(gbase) + (voff)[_i]), (PG8_LAS unsigned*)(lds + (bufoff) + ldsw + _i * 8192), 16, 0, 0); } while (0)
#define PG8_LDA(dst, b, h) do { _Pragma("unroll") for (int m = 0; m < 4; ++m) _Pragma("unroll") for (int k = 0; k < 2; ++k) dst[m][k] = *(const PG8_LAS bf16x8*)(lds + PG8_SA(b, h) + aoff + m * 2048 + k * 1024); } while (0)
#define PG8_LDB(dst, b, h) do { _Pragma("unroll") for (int n = 0; n < 2; ++n) _Pragma("unroll") for (int k = 0; k < 2; ++k) dst[n][k] = *(const PG8_LAS bf16x8*)(lds + PG8_SB(b, h) + boff + n * 2048 + k * 1024); } while (0)
#define PG8_MMA(ai, bj, At, Bt) do { __builtin_amdgcn_s_setprio(1); _Pragma("unroll") for (int m = 0; m < 4; ++m) _Pragma("unroll") for (int n = 0; n < 2; ++n) _Pragma("unroll") for (int k = 0; k < 2; ++k) \
        acc[ai][bj][m][n] = __builtin_amdgcn_mfma_f32_16x16x32_bf16(Bt[n][k], At[m][k], acc[ai][bj][m][n], 0, 0, 0); __builtin_amdgcn_s_setprio(0); } while (0)
#define PG8_WAIT_V(n) asm volatile("s_waitcnt vmcnt(" #n ")" ::: "memory")
#define PG8_WAIT_L(n) asm volatile("s_waitcnt lgkmcnt(" #n ")" ::: "memory")
#define PG8_BAR __builtin_amdgcn_s_barrier()
#define PG8_SCHED __builtin_amdgcn_sched_barrier(0)
    Unit cur, nxt; int ui = 0;
    if (!S.next(0, cur)) return;
    f32x4 acc[2][2][4][2];
#pragma unroll
    for (int a = 0; a < 2; ++a)
#pragma unroll
        for (int b = 0; b < 2; ++b)
#pragma unroll
            for (int m = 0; m < 4; ++m)
#pragma unroll
                for (int n = 0; n < 2; ++n) acc[a][b][m][n] = (f32x4){0.f, 0.f, 0.f, 0.f};
    bf16x8 At[4][2], B0[2][2], B1[2][2];
    const char* cA = (const char*)g.A + (size_t)cur.pm * tstep; const char* cB = (const char*)g.Bt + (size_t)cur.pn * tstep;
    S.a_ready(cur);
    if constexpr (SP2) {
        PG8_STAGE(PG8_SB(0, 0), cB, voffB); PG8_STAGE(PG8_SB(0, 1), cB + hstep, voffB); PG8_STAGE(PG8_SA(0, 0), cA, voffA); PG8_STAGE(PG8_SA(0, 1), cA + hstep, voffA);
        if (wr == 1) PG8_BAR;
        PG8_WAIT_V(2); PG8_BAR;
        PG8_STAGE(PG8_SB(1, 0), cB + kstep, voffB); PG8_STAGE(PG8_SA(1, 0), cA + kstep, voffA); PG8_STAGE(PG8_SB(1, 1), cB + hstep + kstep, voffB);
        PG8_WAIT_V(6); PG8_BAR;
    } else {
        PG8_STAGE(PG8_SB(0, 0), cB, voffB); PG8_STAGE(PG8_SA(0, 0), cA, voffA); PG8_STAGE(PG8_SB(0, 1), cB + hstep, voffB); PG8_STAGE(PG8_SA(0, 1), cA + hstep, voffA);
        if (wr == 1) PG8_BAR;
        PG8_WAIT_V(4); PG8_BAR;
        PG8_STAGE(PG8_SB(1, 0), cB + kstep, voffB); PG8_STAGE(PG8_SA(1, 0), cA + kstep, voffA); PG8_STAGE(PG8_SB(1, 1), cB + hstep + kstep, voffB);
        PG8_WAIT_V(6); PG8_BAR;
    }
    for (;;) {
        const bool has_next = S.next(ui + 1, nxt);
        const char* nA = has_next ? (const char*)g.A + (size_t)nxt.pm * tstep : cA; const char* nB = has_next ? (const char*)g.Bt + (size_t)nxt.pn * tstep : cB;
        for (int t = 0; t < nt; t += 2) {
            const bool last = (t == nt - 2);
            const char* a1 = cA + (size_t)(t + 1) * kstep;
            const char* a2 = last ? nA : cA + (size_t)(t + 2) * kstep; const char* b2 = last ? nB : cB + (size_t)(t + 2) * kstep;
            const char* a3 = a2 + kstep; const char* b3 = b2 + kstep;
            if (last && has_next) S.a_ready(nxt);
            if constexpr (SP2) {
            PG8_LDB(B0, 0, 0); PG8_LDB(B1, 0, 1); PG8_SCHED; PG8_LDA(At, 0, 0); PG8_STAGE(PG8_SA(1, 1), a1 + hstep, voffA);
            PG8_WAIT_V(8); PG8_WAIT_L(0); PG8_BAR; PG8_MMA(0, 0, At, B0); PG8_MMA(0, 1, At, B1); PG8_BAR; PG8_SCHED;
            PG8_LDA(At, 0, 1); PG8_STAGE(PG8_SB(0, 0), b2, voffB); PG8_STAGE(PG8_SB(0, 1), b2 + hstep, voffB); PG8_STAGE(PG8_SA(0, 0), a2, voffA);
            PG8_WAIT_V(8); PG8_WAIT_L(0); PG8_BAR; PG8_MMA(1, 0, At, B0); PG8_MMA(1, 1, At, B1); PG8_BAR; PG8_SCHED;
            PG8_LDB(B0, 1, 0); PG8_LDB(B1, 1, 1); PG8_SCHED; PG8_LDA(At, 1, 0); PG8_STAGE(PG8_SA(0, 1), a2 + hstep, voffA);
            PG8_WAIT_V(8); PG8_WAIT_L(0); PG8_BAR; PG8_MMA(0, 0, At, B0); PG8_MMA(0, 1, At, B1); PG8_BAR; PG8_SCHED;
            PG8_LDA(At, 1, 1); PG8_STAGE(PG8_SB(1, 0), b3, voffB); PG8_STAGE(PG8_SB(1, 1), b3 + hstep, voffB); PG8_STAGE(PG8_SA(1, 0), a3, voffA);
            PG8_WAIT_V(8); PG8_WAIT_L(0); PG8_BAR; PG8_MMA(1, 0, At, B0); PG8_MMA(1, 1, At, B1); PG8_BAR; PG8_SCHED;
            } else {
            PG8_LDB(B0, 0, 0); PG8_SCHED; PG8_LDA(At, 0, 0); PG8_STAGE(PG8_SA(1, 1), a1 + hstep, voffA);
            PG8_WAIT_L(8); PG8_BAR; PG8_WAIT_L(0); PG8_MMA(0, 0, At, B0); PG8_BAR; PG8_SCHED;
            PG8_LDB(B1, 0, 1); PG8_STAGE(PG8_SB(0, 0), b2, voffB);
            PG8_BAR; PG8_WAIT_L(0); PG8_MMA(0, 1, At, B1); PG8_BAR;
            PG8_LDA(At, 0, 1); PG8_STAGE(PG8_SA(0, 0), a2, voffA);
            PG8_BAR; PG8_WAIT_L(0); PG8_MMA(1, 0, At, B0); PG8_BAR; PG8_SCHED;
            PG8_STAGE(PG8_SB(0, 1), b2 + hstep, voffB);
            PG8_WAIT_V(6); PG8_BAR; PG8_MMA(1, 1, At, B1); PG8_BAR;
            PG8_LDB(B0, 1, 0); PG8_SCHED; PG8_LDA(At, 1, 0); PG8_STAGE(PG8_SA(0, 1), a2 + hstep, voffA);
            PG8_WAIT_L(8); PG8_BAR; PG8_WAIT_L(0); PG8_MMA(0, 0, At, B0); PG8_BAR; PG8_SCHED;
            PG8_LDB(B1, 1, 1); PG8_STAGE(PG8_SB(1, 0), b3, voffB);
            PG8_BAR; PG8_WAIT_L(0); PG8_MMA(0, 1, At, B1); PG8_BAR;
            PG8_LDA(At, 1, 1); PG8_STAGE(PG8_SA(1, 0), a3, voffA);
            PG8_BAR; PG8_WAIT_L(0); PG8_MMA(1, 0, At, B0); PG8_BAR; PG8_SCHED;
            PG8_STAGE(PG8_SB(1, 1), b3 + hstep, voffB);
            PG8_WAIT_V(6); PG8_BAR; PG8_MMA(1, 1, At, B1); PG8_BAR;
            }
        }
        if constexpr (ALIGN_EPI) { if (wr == 0) PG8_BAR; }
        if constexpr (!Epi::AFTER_DRAIN) { E(acc, cur, wr, wc, fr, fq); S.done(cur); }
        if (!has_next) break;
#pragma unroll
        for (int a = 0; a < 2; ++a)
#pragma unroll
            for (int b = 0; b < 2; ++b)
#pragma unroll
                for (int m = 0; m < 4; ++m)
#pragma unroll
                    for (int n = 0; n < 2; ++n) acc[a][b][m][n] = (f32x4){0.f, 0.f, 0.f, 0.f};
        cur = nxt; cA = nA; cB = nB; ++ui;
        if constexpr (ALIGN_EPI) { if (wr == 1) PG8_BAR; }
    }
    PG8_WAIT_V(0);
    if constexpr (!ALIGN_EPI) { if (wr == 0) PG8_BAR; }
    PG8_BAR;
    if constexpr (Epi::AFTER_DRAIN) { E.fused(acc, cur, wr, wc, fr, fq, lds, wid, lane); S.done(cur); }
#undef PG8_SA
#undef PG8_SB
#undef PG8_STAGE
#undef PG8_LDA
#undef PG8_LDB
#undef PG8_MMA
#undef PG8_WAIT_V
#undef PG8_WAIT_L
#undef PG8_BAR
#undef PG8_SCHED
}
}

#ifndef MK_ONE_LAUNCH
#define MK_ONE_LAUNCH 1
#endif
constexpr int D = 1024, DFF = 2816, DIN = 1792, DEPTH = 4, SEQ = 8192;
constexpr int MP = 16384, MS = 128, MV = MP + MS, MT = 16640;
constexpr int NGU = 2 * DFF;
constexpr int NMODC = 4 * 9 * D;
constexpr int NBATCH = 130;
constexpr float ALPHA = 1.6817928305074290f;
constexpr float LN_EPS = 1e-5f, RMS_EPS = 1e-6f;
constexpr int NPH = 3 + 10 * DEPTH;
constexpr size_t O_YP = 0, O_YS = 16777216, O_PC = 16908288, O_PP = 16912384, O_PK = 16943104, O_PV = 17074176, O_SC = 17205248, O_SP = 17467392, O_SK = 19433472, O_SV = 27822080;
constexpr size_t WL_BYTES = 40370176;
constexpr size_t WO_GU1 = 0, WO_D1 = 11534336, WO_IN = 17301504, WO_OUT = 20971520, WO_GU2 = 23068672, WO_D2 = 34603008;
constexpr size_t WS_W = 1048576;
constexpr size_t WS_POOLW = WS_W + 4 * WL_BYTES;
constexpr size_t WS_AC = WS_POOLW + 131072;
constexpr size_t WS_MOD = WS_AC + 524288;
constexpr size_t WS_XB = WS_MOD + (size_t)NBATCH * NMODC * 4;
constexpr size_t WS_YB = WS_XB + (size_t)MT * D * 4;
constexpr size_t WS_HB = WS_YB + (size_t)MT * D * 4;
constexpr size_t WS_HID = WS_HB + (size_t)MT * D * 2;
constexpr size_t WS_PROJ = WS_HID + (size_t)MT * DFF * 2;
constexpr size_t WS_YMIX = WS_PROJ + (size_t)MT * DIN * 2;
constexpr size_t WS_END = WS_YMIX + (size_t)MT * D * 2;
static_assert((size_t)NMODC * D * 2 <= (size_t)MT * DFF * 2, "w_ada copy fits the hidden buffer");
static_assert(WS_END < 600000000ull, "workspace");
constexpr int LDS_BYTES = 147456;
constexpr int NWAVES = 8;

#define LAS __attribute__((address_space(3)))
typedef unsigned short bf16;
typedef unsigned u32x4 __attribute__((ext_vector_type(4)));
typedef unsigned u32x2 __attribute__((ext_vector_type(2)));
typedef float f32x4 __attribute__((ext_vector_type(4)));
typedef short bf16x8 __attribute__((ext_vector_type(8)));

__device__ __forceinline__ unsigned f2bf(float f) { unsigned u = __builtin_bit_cast(unsigned, f); return (u + 0x7fffu + ((u >> 16) & 1u)) >> 16; }
__device__ __forceinline__ unsigned pk2(float lo, float hi) { return f2bf(lo) | (f2bf(hi) << 16); }
__device__ __forceinline__ float bf2f(unsigned short u) { return __builtin_bit_cast(float, (unsigned)u << 16); }
__device__ __forceinline__ float wave_sum(float v) {
#pragma unroll
    for (int o = 1; o < 64; o <<= 1) v += __shfl_xor(v, o);
    return v;
}
__device__ __forceinline__ float wave_max(float v) {
#pragma unroll
    for (int o = 1; o < 64; o <<= 1) v = fmaxf(v, __shfl_xor(v, o));
    return v;
}
__device__ __forceinline__ float silu_f(float g) { return g * __builtin_amdgcn_rcpf(1.0f + __expf(-g)); }
__device__ __forceinline__ int batch_of_row(int r) { return r < SEQ ? 0 : (r < MP ? 1 : (r - MP + 2 < NBATCH ? r - MP + 2 : NBATCH - 1)); }

namespace pg8 {
struct EpiSwiGLU {
    static constexpr bool PERM = true, AFTER_DRAIN = false;
    bf16_t* H;
    __device__ __forceinline__ void operator()(const f32x4 (&acc)[2][2][4][2], const Unit& u, int wr, int wc, int fr, int fq) const {
        const int row0 = u.pm * BM + wr * 64 + fr, col0 = u.pn * 128 + wc * 32 + 8 * fq;
#pragma unroll
        for (int ai = 0; ai < 2; ++ai)
#pragma unroll
            for (int m = 0; m < 4; ++m) {
                bf16_t* rowp = H + (size_t)(row0 + ai * HALF + m * 16) * DFF + col0;
                const f32x4 g0 = acc[ai][0][m][0], g1 = acc[ai][0][m][1], u0 = acc[ai][1][m][0], u1 = acc[ai][1][m][1];
                u32x4 w;
                w.x = cvt_pk_bf16(silu_f(g0[0]) * u0[0], silu_f(g0[1]) * u0[1]); w.y = cvt_pk_bf16(silu_f(g0[2]) * u0[2], silu_f(g0[3]) * u0[3]);
                w.z = cvt_pk_bf16(silu_f(g1[0]) * u1[0], silu_f(g1[1]) * u1[1]); w.w = cvt_pk_bf16(silu_f(g1[2]) * u1[2], silu_f(g1[3]) * u1[3]);
                *(u32x4*)rowp = w;
            }
    }
};
struct EpiResid {
    static constexpr bool PERM = false, AFTER_DRAIN = false;
    const float* x; float* y; const float* gate; float scale;
    __device__ __forceinline__ void operator()(const f32x4 (&acc)[2][2][4][2], const Unit& u, int wr, int wc, int fr, int fq) const {
        const int col0 = u.pn * BM + wc * 32 + 4 * fq;
#pragma unroll
        for (int ai = 0; ai < 2; ++ai)
#pragma unroll
            for (int m = 0; m < 4; ++m) {
                const int r = u.pm * BM + ai * HALF + wr * 64 + m * 16 + fr;
                const float* gp = gate + (size_t)batch_of_row(r) * NMODC + col0;
                const size_t off = (size_t)r * D + col0;
#pragma unroll
                for (int bj = 0; bj < 2; ++bj)
#pragma unroll
                    for (int n = 0; n < 2; ++n) {
                        const f32x4 xv = *(const f32x4*)(x + off + bj * HALF + n * 16), gv = *(const f32x4*)(gp + bj * HALF + n * 16);
                        *(f32x4*)(y + off + bj * HALF + n * 16) = xv * ALPHA + gv * scale * acc[ai][bj][m][n];
                    }
            }
    }
};
struct EpiMod {
    static constexpr bool PERM = false, AFTER_DRAIN = false;
    float* out; const float* bias;
    __device__ __forceinline__ void operator()(const f32x4 (&acc)[2][2][4][2], const Unit& u, int wr, int wc, int fr, int fq) const {
        const int col0 = u.pn * BM + wc * 32 + 4 * fq;
#pragma unroll
        for (int ai = 0; ai < 2; ++ai)
#pragma unroll
            for (int m = 0; m < 4; ++m) {
                const int r = ai * HALF + wr * 64 + m * 16 + fr;
                if (r < NBATCH) {
#pragma unroll
                    for (int bj = 0; bj < 2; ++bj)
#pragma unroll
                        for (int n = 0; n < 2; ++n) {
                            const int c = col0 + bj * HALF + n * 16;
                            *(f32x4*)(out + (size_t)r * NMODC + c) = acc[ai][bj][m][n] + *(const f32x4*)(bias + c);
                        }
                }
            }
    }
};
}

struct Args { const float* in[25]; float* out; unsigned char* ws; int ph_lo, ph_hi; };
typedef const __attribute__((address_space(4))) Args* kargs_t;
struct Ctx {
    kargs_t ap;
    float* out; unsigned char* ws;
    LAS unsigned char* lds;
    int tid, lane, wave, G, bid;
};
#define IN_XP 0
#define IN_XS 1
#define IN_SCONV 2
#define IN_SPOOL 3
#define IN_CK 4
#define IN_CV 5
#define IN_CP 6
#define IN_CS 7
#define IN_LNG 8
#define IN_LNB 9
#define IN_WADA 10
#define IN_BADA 11
#define IN_F1G 12
#define IN_F1U 13
#define IN_F1D 14
#define IN_WIN 15
#define IN_CONVW 16
#define IN_POOLW 17
#define IN_PSCALE 18
#define IN_SINKS 19
#define IN_MIXG 20
#define IN_WOUT 21
#define IN_F2G 22
#define IN_F2U 23
#define IN_F2D 24

__device__ __forceinline__ void transpose_item(const float* W, int K, int N, bf16* WT, int k0, int n0, int drow0, LAS float* scr, int lane) {
#pragma unroll 8
    for (int i = 0; i < 32; ++i) { const int kk = 2 * i + (lane >> 5); scr[kk * 33 + (lane & 31)] = W[(size_t)(k0 + kk) * N + n0 + (lane & 31)]; }
    asm volatile("s_waitcnt lgkmcnt(0)" ::: "memory");
    const int c = lane & 7;
#pragma unroll
    for (int j = 0; j < 4; ++j) { const int n = (lane >> 3) + 8 * j; const LAS float* s = scr + (8 * c) * 33 + n;
        u32x4 o; o.x = pk2(s[0 * 33], s[1 * 33]); o.y = pk2(s[2 * 33], s[3 * 33]); o.z = pk2(s[4 * 33], s[5 * 33]); o.w = pk2(s[6 * 33], s[7 * 33]);
        *(u32x4*)(WT + (size_t)(drow0 + n) * K + k0 + 8 * c) = o; }
    asm volatile("s_waitcnt lgkmcnt(0)" ::: "memory");
}
constexpr int IT_G = 1408, IT_IN = 896, IT_O = 512, IT_ADA = 4608, IT_LB = 6 * IT_G + IT_IN + IT_O + IT_ADA;
__device__ __forceinline__ void p0_prologue(const Ctx& C) {
    LAS float* scr = (LAS float*)(C.lds + C.wave * 16384);
    const int gw = C.bid * NWAVES + C.wave, NGW = C.G * NWAVES, lane = C.lane;
    unsigned char* ws = C.ws;
    const int NITEMS = DEPTH * IT_LB + 32;
    for (int it = gw; it < NITEMS; it += NGW) {
        const float* W; int K, N, mode = 0; bf16* WT; int r;
        if (it < DEPTH * IT_LB) {
            const int l = it / IT_LB; r = it % IT_LB;
            unsigned char* wl = ws + WS_W + (size_t)l * WL_BYTES;
            const size_t fo = (size_t)l * D * DFF;
            if (r < IT_G) { W = C.ap->in[IN_F1G] + fo; K = D; N = DFF; WT = (bf16*)(wl + WO_GU1); mode = 1; }
            else if ((r -= IT_G) < IT_G) { W = C.ap->in[IN_F1U] + fo; K = D; N = DFF; WT = (bf16*)(wl + WO_GU1); mode = 2; }
            else if ((r -= IT_G) < IT_G) { W = C.ap->in[IN_F1D] + fo; K = DFF; N = D; WT = (bf16*)(wl + WO_D1); }
            else if ((r -= IT_G) < IT_IN) { W = C.ap->in[IN_WIN] + (size_t)l * D * DIN; K = D; N = DIN; WT = (bf16*)(wl + WO_IN); }
            else if ((r -= IT_IN) < IT_O) { W = C.ap->in[IN_WOUT] + (size_t)l * D * D; K = D; N = D; WT = (bf16*)(wl + WO_OUT); }
            else if ((r -= IT_O) < IT_G) { W = C.ap->in[IN_F2G] + fo; K = D; N = DFF; WT = (bf16*)(wl + WO_GU2); mode = 1; }
            else if ((r -= IT_G) < IT_G) { W = C.ap->in[IN_F2U] + fo; K = D; N = DFF; WT = (bf16*)(wl + WO_GU2); mode = 2; }
            else if ((r -= IT_G) < IT_G) { W = C.ap->in[IN_F2D] + fo; K = DFF; N = D; WT = (bf16*)(wl + WO_D2); }
            else { r -= IT_G; W = C.ap->in[IN_WADA] + (size_t)l * D * 9 * D; K = D; N = 9 * D; WT = (bf16*)(ws + WS_HID) + (size_t)l * 9 * D * D; }
        } else {
            r = it - DEPTH * IT_LB; const int mat = r >> 1; r &= 1;
            W = C.ap->in[IN_POOLW] + (size_t)mat * 4096; K = 64; N = 64; WT = (bf16*)(ws + WS_POOLW) + (size_t)mat * 4096;
        }
        const int nblk = N / 32, kb = r / nblk, nb = r % nblk, n0 = 32 * nb;
        const int drow0 = mode == 0 ? n0 : (256 * (n0 >> 7) + (n0 & 127) + (mode == 2 ? 128 : 0));
        transpose_item(W, K, N, WT, 64 * kb, n0, drow0, scr, lane);
    }
    float* XB = (float*)(ws + WS_XB); bf16* HB = (bf16*)(ws + WS_HB); bf16* YM = (bf16*)(ws + WS_YMIX); bf16* AC = (bf16*)(ws + WS_AC);
    for (int j = gw; j < MT + 256; j += NGW) {
        if (j < MT) {
            const float* src = j < MP ? C.ap->in[IN_XP] + (size_t)j * D : (j < MV ? C.ap->in[IN_XS] + (size_t)(j - MP) * D : nullptr);
            f32x4* dst = (f32x4*)(XB + (size_t)j * D) + lane;
#pragma unroll
            for (int q = 0; q < 4; ++q) dst[64 * q] = src ? ((const f32x4*)src)[lane + 64 * q] : (f32x4){0.f, 0.f, 0.f, 0.f};
            if (j >= MV) {
                u32x4* h = (u32x4*)(HB + (size_t)j * D) + lane; u32x4* y = (u32x4*)(YM + (size_t)j * D) + lane;
                h[0] = (u32x4){0, 0, 0, 0}; h[64] = (u32x4){0, 0, 0, 0}; y[0] = (u32x4){0, 0, 0, 0}; y[64] = (u32x4){0, 0, 0, 0};
            }
        } else {
            const int r = j - MT;
            const float* src = r < 2 ? C.ap->in[IN_CP] + (size_t)r * D : (r < NBATCH ? C.ap->in[IN_CS] + (size_t)(r - 2) * D : nullptr);
            u32x2* dst = (u32x2*)(AC + (size_t)r * D) + lane;
#pragma unroll
            for (int q = 0; q < 4; ++q) {
                f32x4 v = src ? ((const f32x4*)src)[lane + 64 * q] : (f32x4){0.f, 0.f, 0.f, 0.f};
                u32x2 o; o.x = pk2(silu_f(v.x), silu_f(v.y)); o.y = pk2(silu_f(v.z), silu_f(v.w)); dst[64 * q] = o;
            }
        }
    }
}

__device__ __forceinline__ void ln_phase(const Ctx& C, const float* src, bool do_ln, const float* lg, const float* lb, float* xdst, bf16* hdst, const float* msh, const float* msc) {
    const int gw = C.bid * NWAVES + C.wave, NGW = C.G * NWAVES, lane = C.lane;
    for (int r = gw; r < MV; r += NGW) {
        const f32x4* xr = (const f32x4*)(src + (size_t)r * D) + lane;
        f32x4 v[4];
#pragma unroll
        for (int j = 0; j < 4; ++j) v[j] = xr[64 * j];
        if (do_ln) {
            float s = 0.f;
#pragma unroll
            for (int j = 0; j < 4; ++j) s += (v[j].x + v[j].y) + (v[j].z + v[j].w);
            const float mean = wave_sum(s) * (1.f / D); float s2 = 0.f;
#pragma unroll
            for (int j = 0; j < 4; ++j) { v[j] = v[j] - mean; s2 += (v[j].x * v[j].x + v[j].y * v[j].y) + (v[j].z * v[j].z + v[j].w * v[j].w); }
            const float rstd = 1.f / sqrtf(wave_sum(s2) * (1.f / D) + LN_EPS);
#pragma unroll
            for (int j = 0; j < 4; ++j) v[j] = v[j] * rstd * ((const f32x4*)lg)[lane + 64 * j] + ((const f32x4*)lb)[lane + 64 * j];
            if (xdst) { f32x4* xo = (f32x4*)(xdst + (size_t)r * D) + lane;
#pragma unroll
                for (int j = 0; j < 4; ++j) xo[64 * j] = v[j]; }
        }
        if (hdst) {
            const size_t mo = (size_t)batch_of_row(r) * NMODC;
            u32x2* ho = (u32x2*)(hdst + (size_t)r * D) + lane;
#pragma unroll
            for (int j = 0; j < 4; ++j) {
                const f32x4 sh = ((const f32x4*)(msh + mo))[lane + 64 * j], sc = ((const f32x4*)(msc + mo))[lane + 64 * j];
                const f32x4 h = v[j] * (sc + 1.0f) + sh;
                u32x2 o; o.x = pk2(h.x, h.y); o.y = pk2(h.z, h.w); ho[64 * j] = o;
            }
        }
    }
}

__device__ __forceinline__ void norm_rows256(LAS float* OUT, bf16* Y, const float* g, int wave, int lane) {
    const f32x4 gg = ((const f32x4*)g)[lane];
#pragma unroll
    for (int i = 0; i < 8; ++i) {
        const int row = wave * 8 + i;
        const f32x4 v = *(const LAS f32x4*)(OUT + row * 260 + lane * 4);
        const float ss = wave_sum((v.x * v.x + v.y * v.y) + (v.z * v.z + v.w * v.w));
        const float sc = 1.0f / sqrtf(ss * (1.f / 256.f) + RMS_EPS);
        u32x2 o; o.x = pk2(v.x * sc * gg.x, v.y * sc * gg.y); o.y = pk2(v.z * sc * gg.z, v.w * sc * gg.w);
        *(u32x2*)(Y + (size_t)row * D + lane * 4) = o;
    }
}

__device__ __forceinline__ void mixer_prompt_tile(const Ctx& C, int l, int tile) {
    const int tid = C.tid, wave = C.wave, lane = C.lane, fr = lane & 15, fq = lane >> 4;
    const int b = tile >> 7, t0 = (tile & 127) * 64;
    const bf16* P = (const bf16*)(C.ws + WS_PROJ) + (size_t)(b * SEQ) * DIN;
    bf16* Y = (bf16*)(C.ws + WS_YMIX) + (size_t)(b * SEQ + t0) * D;
    LAS unsigned char* lds = C.lds;
    LAS float* OUT = (LAS float*)lds;
    LAS bf16* UT = (LAS bf16*)(lds + 66560);
    LAS bf16* PL = (LAS bf16*)(lds + 66560 + 40448);
    const float* mixg = C.ap->in[IN_MIXG] + (size_t)l * D;
    __syncthreads();
    {
        const int c = tid & 255, half = tid >> 8, tb = t0 + half * 32;
        const float* cw = C.ap->in[IN_CONVW] + (size_t)l * 768;
        const float w0 = cw[c], w1 = cw[256 + c], w2 = cw[512 + c];
        float cm2 = 0.f, cm1 = 0.f;
        if (tb >= 2) { const bf16* p2 = P + (size_t)(tb - 2) * DIN; cm2 = bf2f(p2[256 + c]) * bf2f(p2[512 + c]); cm1 = bf2f(p2[DIN + 256 + c]) * bf2f(p2[DIN + 512 + c]); }
        float* pc = C.out + O_PC + (size_t)((l * 2 + b) * 2) * 256;
#pragma unroll 4
        for (int i = 0; i < 32; ++i) {
            const bf16* p = P + (size_t)(tb + i) * DIN;
            const float gb = bf2f(p[c]), cv = bf2f(p[256 + c]) * bf2f(p[512 + c]);
            OUT[(half * 32 + i) * 260 + c] = gb * (w0 * cm2 + w1 * cm1 + w2 * cv);
            if (tb + i >= SEQ - 2) pc[(tb + i - (SEQ - 2)) * 256 + c] = cv;
            cm2 = cm1; cm1 = cv;
        }
    }
    for (int ch = tid; ch < 79 * 32; ch += 512) {
        const int row = ch >> 5, cc = ch & 31, t = t0 - 15 + row;
        u32x4 v = (u32x4){0, 0, 0, 0};
        if (t >= 0) v = *(const u32x4*)(P + (size_t)t * DIN + 768 + cc * 8);
        *(LAS u32x4*)(UT + row * 256 + cc * 8) = v;
    }
    __syncthreads();
    norm_rows256(OUT, Y, mixg, wave, lane);
    {
        const int c = tid & 255, half = tid >> 8, g = c >> 6, w = 2 << g, r0 = 15 + half * 32;
        float s = 0.f;
        for (int j = 1; j < w; ++j) s += bf2f(UT[(r0 - j) * 256 + c]);
        float* pp = C.out + O_PP + (size_t)((l * 2 + b) * 15) * 256;
        for (int i = 0; i < 32; ++i) {
            const float uu = bf2f(UT[(r0 + i) * 256 + c]);
            s += uu;
            const int t = t0 + half * 32 + i;
            const float cnt = (float)(t + 1 < w ? t + 1 : w);
            PL[(half * 32 + i) * 264 + c] = (bf16)f2bf(s / cnt - uu);
            s -= bf2f(UT[(r0 + i - w + 1) * 256 + c]);
            if (t >= SEQ - 15) pp[(t - (SEQ - 15)) * 256 + c] = uu;
        }
    }
    __syncthreads();
    {
        const int g = wave >> 1, dbase = (wave & 1) * 2;
        const bf16* PW = (const bf16*)(C.ws + WS_POOLW) + (size_t)((l * 4 + g) * 64) * 64;
        const float* psc = C.ap->in[IN_PSCALE] + (size_t)l * 256;
        bf16x8 wf[2][2];
#pragma unroll
        for (int di = 0; di < 2; ++di)
#pragma unroll
            for (int kk = 0; kk < 2; ++kk) wf[di][kk] = *(const bf16x8*)(PW + (size_t)(16 * (dbase + di) + fr) * 64 + 32 * kk + 8 * fq);
#pragma unroll
        for (int tb = 0; tb < 4; ++tb) {
            const bf16x8 p0 = *(const LAS bf16x8*)(PL + (16 * tb + fr) * 264 + g * 64 + 8 * fq), p1 = *(const LAS bf16x8*)(PL + (16 * tb + fr) * 264 + g * 64 + 32 + 8 * fq);
#pragma unroll
            for (int di = 0; di < 2; ++di) {
                f32x4 a = (f32x4){0.f, 0.f, 0.f, 0.f};
                a = __builtin_amdgcn_mfma_f32_16x16x32_bf16(wf[di][0], p0, a, 0, 0, 0);
                a = __builtin_amdgcn_mfma_f32_16x16x32_bf16(wf[di][1], p1, a, 0, 0, 0);
                const int col = g * 64 + 16 * (dbase + di) + 4 * fq;
                *(LAS f32x4*)(OUT + (16 * tb + fr) * 260 + col) = a * *(const f32x4*)(psc + col);
            }
        }
    }
    __syncthreads();
    norm_rows256(OUT, Y + 256, mixg + 256, wave, lane);
    __syncthreads();
    {
        const int h = wave, kvh = h >> 2;
        LAS bf16* KS = (LAS bf16*)lds;
        LAS bf16* VT = (LAS bf16*)(lds + 52224);
        LAS float* SSQ = (LAS float*)(lds + 103424);
        for (int ch = tid; ch < 192 * 16; ch += 512) {
            const int key = ch >> 4, dc = ch & 15, t = t0 - 128 + key;
            u32x4 v = (u32x4){0, 0, 0, 0};
            if (t >= 0) v = *(const u32x4*)(P + (size_t)t * DIN + 1536 + dc * 8);
            *(LAS u32x4*)(KS + key * 136 + dc * 8) = v;
        }
        for (int ch = tid; ch < 192 * 16; ch += 512) {
            const int dc = ch / 192, key = ch % 192, t = t0 - 128 + key;
            u32x4 v = (u32x4){0, 0, 0, 0};
            if (t >= 0) v = *(const u32x4*)(P + (size_t)t * DIN + 1664 + dc * 8);
            LAS bf16* vp = VT + (dc * 8) * 200 + key;
            vp[0] = (bf16)(v.x & 0xffffu); vp[200] = (bf16)(v.x >> 16); vp[400] = (bf16)(v.y & 0xffffu); vp[600] = (bf16)(v.y >> 16);
            vp[800] = (bf16)(v.z & 0xffffu); vp[1000] = (bf16)(v.z >> 16); vp[1200] = (bf16)(v.w & 0xffffu); vp[1400] = (bf16)(v.w >> 16);
        }
        bf16x8 qf[4][2];
#pragma unroll
        for (int qb = 0; qb < 4; ++qb)
#pragma unroll
            for (int kk = 0; kk < 2; ++kk) qf[qb][kk] = *(const bf16x8*)(P + (size_t)(t0 + 16 * qb + fr) * DIN + 1024 + h * 64 + 32 * kk + 8 * fq);
        if (t0 >= SEQ - 128) {
            float* pk = C.out + O_PK + (size_t)((l * 2 + b) * 128) * 128; float* pv = C.out + O_PV + (size_t)((l * 2 + b) * 128) * 128;
            for (int idx = tid; idx < 64 * 128; idx += 512) {
                const int row = idx >> 7, col = idx & 127, t = t0 + row;
                pk[(size_t)(t - (SEQ - 128)) * 128 + col] = bf2f(P[(size_t)t * DIN + 1536 + col]);
                pv[(size_t)(t - (SEQ - 128)) * 128 + col] = bf2f(P[(size_t)t * DIN + 1664 + col]);
            }
        }
        __syncthreads();
        const float sink = C.ap->in[IN_SINKS][l * 8 + h];
        const int kmin = 128 - t0;
        f32x4 o[4][4];
#pragma unroll
        for (int qb = 0; qb < 4; ++qb) {
            f32x4 s[12];
#pragma unroll
            for (int kb = 0; kb < 12; ++kb) {
                s[kb] = (f32x4){0.f, 0.f, 0.f, 0.f};
#pragma unroll
                for (int kk = 0; kk < 2; ++kk) {
                    const bf16x8 kf = *(const LAS bf16x8*)(KS + (16 * kb + fr) * 136 + kvh * 64 + 32 * kk + 8 * fq);
                    s[kb] = __builtin_amdgcn_mfma_f32_16x16x32_bf16(kf, qf[qb][kk], s[kb], 0, 0, 0);
                }
            }
            const int qrel = 16 * qb + fr;
            float mx = -1e30f;
#pragma unroll
            for (int kb = 0; kb < 12; ++kb)
#pragma unroll
                for (int j = 0; j < 4; ++j) {
                    const int kidx = 16 * kb + 4 * fq + j;
                    const bool valid = (kidx > qrel) && (kidx <= qrel + 128) && (kidx >= kmin);
                    const float v = valid ? s[kb][j] * 0.125f : -1e30f;
                    s[kb][j] = v; mx = fmaxf(mx, v);
                }
            mx = fmaxf(mx, __shfl_xor(mx, 16)); mx = fmaxf(mx, __shfl_xor(mx, 32)); mx = fmaxf(mx, sink);
            float sum = 0.f;
#pragma unroll
            for (int kb = 0; kb < 12; ++kb)
#pragma unroll
                for (int j = 0; j < 4; ++j) { const float p = __expf(s[kb][j] - mx); s[kb][j] = p; sum += p; }
            sum += __shfl_xor(sum, 16); sum += __shfl_xor(sum, 32);
            const float inv = 1.0f / (sum + __expf(sink - mx));
            bf16x8 pf[6];
#pragma unroll
            for (int c6 = 0; c6 < 6; ++c6) {
                u32x4 w; w.x = pk2(s[2 * c6][0], s[2 * c6][1]); w.y = pk2(s[2 * c6][2], s[2 * c6][3]); w.z = pk2(s[2 * c6 + 1][0], s[2 * c6 + 1][1]); w.w = pk2(s[2 * c6 + 1][2], s[2 * c6 + 1][3]);
                pf[c6] = __builtin_bit_cast(bf16x8, w);
            }
            float ss = 0.f;
#pragma unroll
            for (int db = 0; db < 4; ++db) {
                f32x4 a = (f32x4){0.f, 0.f, 0.f, 0.f};
#pragma unroll
                for (int c6 = 0; c6 < 6; ++c6) {
                    const LAS bf16* vp = VT + (kvh * 64 + 16 * db + fr) * 200 + 32 * c6 + 4 * fq;
                    const u32x2 lo = *(const LAS u32x2*)vp, hi = *(const LAS u32x2*)(vp + 16);
                    u32x4 w; w.x = lo.x; w.y = lo.y; w.z = hi.x; w.w = hi.y;
                    a = __builtin_amdgcn_mfma_f32_16x16x32_bf16(__builtin_bit_cast(bf16x8, w), pf[c6], a, 0, 0, 0);
                }
                a = a * inv; o[qb][db] = a;
                ss += (a.x * a.x + a.y * a.y) + (a.z * a.z + a.w * a.w);
            }
            ss += __shfl_xor(ss, 16); ss += __shfl_xor(ss, 32);
            if (fq == 0) SSQ[h * 64 + 16 * qb + fr] = ss;
        }
        __syncthreads();
        const float* ga = mixg + 512 + h * 64 + 4 * fq;
#pragma unroll
        for (int qb = 0; qb < 4; ++qb) {
            float tot = 0.f;
#pragma unroll
            for (int hh = 0; hh < 8; ++hh) tot += SSQ[hh * 64 + 16 * qb + fr];
            const float sc = 1.0f / sqrtf(tot * (1.f / 512.f) + RMS_EPS);
            bf16* yr = Y + (size_t)(16 * qb + fr) * D + 512 + h * 64 + 4 * fq;
#pragma unroll
            for (int db = 0; db < 4; ++db) {
                const f32x4 gg = *(const f32x4*)(ga + 16 * db), a = o[qb][db];
                u32x2 w; w.x = pk2(a.x * sc * gg.x, a.y * sc * gg.y); w.y = pk2(a.z * sc * gg.z, a.w * sc * gg.w);
                *(u32x2*)(yr + 16 * db) = w;
            }
        }
    }
}

__device__ __forceinline__ void mixer_sample(const Ctx& C, int l, int s) {
    const int tid = C.tid, wave = C.wave, lane = C.lane;
    const bf16* PR = (const bf16*)(C.ws + WS_PROJ) + (size_t)(MP + s) * DIN;
    bf16* Y = (bf16*)(C.ws + WS_YMIX) + (size_t)(MP + s) * D;
    LAS unsigned char* lds = C.lds;
    LAS float* KL = (LAS float*)lds;
    LAS float* VL = (LAS float*)(lds + 66048);
    LAS float* YS = (LAS float*)(lds + 132096);
    LAS float* PLS = (LAS float*)(lds + 136192);
    LAS float* QL = (LAS float*)(lds + 137216);
    LAS float* PB = (LAS float*)(lds + 139264);
    LAS float* WS2 = (LAS float*)(lds + 143360);
    const float* mixg = C.ap->in[IN_MIXG] + (size_t)l * D;
    __syncthreads();
    if (tid < 256) {
        const int c = tid;
        const float gb = bf2f(PR[c]), cv = bf2f(PR[256 + c]) * bf2f(PR[512 + c]);
        const float* sc = C.ap->in[IN_SCONV] + (size_t)((l * MS + s) * 2) * 256;
        const float s0 = sc[c], s1 = sc[256 + c];
        const float* cw = C.ap->in[IN_CONVW] + (size_t)l * 768;
        YS[c] = gb * (cw[c] * s0 + cw[256 + c] * s1 + cw[512 + c] * cv);
        float* oc = C.out + O_SC + (size_t)((l * MS + s) * 2) * 256;
        oc[c] = s1; oc[256 + c] = cv;
    } else {
        const int c = tid - 256, g = c >> 6, w = 2 << g;
        const float uu = bf2f(PR[768 + c]);
        const float* sp = C.ap->in[IN_SPOOL] + (size_t)((l * MS + s) * 15) * 256;
        float* op = C.out + O_SP + (size_t)((l * MS + s) * 15) * 256;
        float sum = uu;
#pragma unroll
        for (int j = 0; j < 15; ++j) {
            const float v = sp[(14 - j) * 256 + c];
            if (j < w - 1) sum += v;
            if (j < 14) op[(13 - j) * 256 + c] = v;
        }
        op[14 * 256 + c] = uu;
        PLS[c] = sum / (float)w - uu;
    }
    QL[tid] = bf2f(PR[1024 + tid]);
    {
        const float* ck = C.ap->in[IN_CK] + (size_t)(l * MS + s) * 16384; const float* cvp = C.ap->in[IN_CV] + (size_t)(l * MS + s) * 16384;
        float* ok = C.out + O_SK + (size_t)(l * MS + s) * 16384; float* ov = C.out + O_SV + (size_t)(l * MS + s) * 16384;
        for (int ch = tid; ch < 128 * 32; ch += 512) {
            const int key = ch >> 5, c4 = (ch & 31) * 4;
            f32x4 kv, vv;
            if (key < 127) { kv = *(const f32x4*)(ck + (size_t)(key + 1) * 128 + c4); vv = *(const f32x4*)(cvp + (size_t)(key + 1) * 128 + c4); }
            else { kv = (f32x4){bf2f(PR[1536 + c4]), bf2f(PR[1536 + c4 + 1]), bf2f(PR[1536 + c4 + 2]), bf2f(PR[1536 + c4 + 3])};
                   vv = (f32x4){bf2f(PR[1664 + c4]), bf2f(PR[1664 + c4 + 1]), bf2f(PR[1664 + c4 + 2]), bf2f(PR[1664 + c4 + 3])}; }
            *(f32x4*)(ok + (size_t)key * 128 + c4) = kv; *(f32x4*)(ov + (size_t)key * 128 + c4) = vv;
            LAS float* kd = KL + key * 129 + c4; LAS float* vd = VL + key * 129 + c4;
            kd[0] = kv.x; kd[1] = kv.y; kd[2] = kv.z; kd[3] = kv.w; vd[0] = vv.x; vd[1] = vv.y; vd[2] = vv.z; vd[3] = vv.w;
        }
    }
    __syncthreads();
    if (tid < 256) {
        const int g = tid >> 6, dd = tid & 63;
        const float* pw = C.ap->in[IN_POOLW] + (size_t)((l * 4 + g) * 64) * 64 + dd;
        float acc = 0.f;
#pragma unroll 8
        for (int c = 0; c < 64; ++c) acc += PLS[g * 64 + c] * pw[c * 64];
        YS[256 + tid] = acc * C.ap->in[IN_PSCALE][l * 256 + tid];
    }
    {
        const int h = wave, kvh = h >> 2;
        const float sink = C.ap->in[IN_SINKS][l * 8 + h];
        float s0 = 0.f, s1 = 0.f;
#pragma unroll 8
        for (int d = 0; d < 64; ++d) { const float q = QL[h * 64 + d]; s0 += q * KL[lane * 129 + kvh * 64 + d]; s1 += q * KL[(lane + 64) * 129 + kvh * 64 + d]; }
        s0 *= 0.125f; s1 *= 0.125f;
        const float mx = fmaxf(wave_max(fmaxf(s0, s1)), sink);
        const float p0 = __expf(s0 - mx), p1 = __expf(s1 - mx);
        const float inv = 1.0f / (wave_sum(p0 + p1) + __expf(sink - mx));
        PB[h * 128 + lane] = p0; PB[h * 128 + 64 + lane] = p1;
        asm volatile("s_waitcnt lgkmcnt(0)" ::: "memory");
        float acc = 0.f;
#pragma unroll 8
        for (int j = 0; j < 128; ++j) acc += PB[h * 128 + j] * VL[j * 129 + kvh * 64 + lane];
        YS[512 + h * 64 + lane] = acc * inv;
    }
    __syncthreads();
    {
        const float v0 = YS[tid], v1 = YS[tid + 512];
        const float a = wave_sum(v0 * v0), bsum = wave_sum(v1 * v1);
        if (lane == 0) { WS2[wave * 2] = a; WS2[wave * 2 + 1] = bsum; }
        __syncthreads();
        float seg = 0.f, seg2 = 0.f;
        const int wlo = tid < 256 ? 0 : 4;
#pragma unroll
        for (int w = 0; w < 4; ++w) seg += WS2[(wlo + w) * 2];
#pragma unroll
        for (int w = 0; w < 8; ++w) seg2 += WS2[w * 2 + 1];
        Y[tid] = (bf16)f2bf(v0 / sqrtf(seg * (1.f / 256.f) + RMS_EPS) * mixg[tid]);
        Y[tid + 512] = (bf16)f2bf(v1 / sqrtf(seg2 * (1.f / 512.f) + RMS_EPS) * mixg[tid + 512]);
    }
}

__global__ void __launch_bounds__(NWAVES * 64, 2) fwd_kernel(Args args) {
    extern __shared__ __attribute__((aligned(16))) unsigned char lds_raw[];
    cg::grid_group grid = cg::this_grid();
    const int ph_lo = args.ph_lo, ph_hi = args.ph_hi;
    for (int ph = ph_lo; ph < ph_hi; ++ph) {
        if (ph > ph_lo) grid.sync();
        kargs_t ap = (kargs_t)__builtin_amdgcn_kernarg_segment_ptr(); asm volatile("" : "+s"(ap));
        int tid = threadIdx.x; asm volatile("" : "+v"(tid));
        Ctx C; C.ap = ap; C.out = ap->out; C.ws = ap->ws; C.lds = (LAS unsigned char*)lds_raw;
        C.tid = tid; C.lane = tid & 63; C.wave = __builtin_amdgcn_readfirstlane(tid >> 6); C.G = gridDim.x; C.bid = blockIdx.x;
        unsigned char* ws = C.ws;
        float* XB = (float*)(ws + WS_XB); float* YB = (float*)(ws + WS_YB); bf16* HB = (bf16*)(ws + WS_HB); bf16* HID = (bf16*)(ws + WS_HID);
        bf16* PROJ = (bf16*)(ws + WS_PROJ); bf16* YMIX = (bf16*)(ws + WS_YMIX); float* MOD = (float*)(ws + WS_MOD);
        if (ph == 0) { p0_prologue(C); continue; }
        if (ph == 1) {
            pg8::Gemm g{(const bf16*)(ws + WS_AC), (const bf16*)(ws + WS_HID), 256, NMODC, D}; pg8::StaticOrder S; S.init(256, NMODC, C.G, C.bid);
            pg8::EpiMod E{MOD, C.ap->in[IN_BADA]};
            pg8::gemm_phase<pg8::EpiMod, pg8::StaticOrder, true, true>(C.lds, g, S, E); continue;
        }
        if (ph == 2) { ln_phase(C, XB, false, nullptr, nullptr, nullptr, HB, MOD + 0 * D, MOD + 1 * D); continue; }
        const int l = (ph - 3) / 10, k = (ph - 3) % 10;
        unsigned char* wl = ws + WS_W + (size_t)l * WL_BYTES;
        const float* modl = MOD + (size_t)l * 9 * D;
        if (k == 0 || k == 7) {
            pg8::Gemm g{HB, (const bf16*)(wl + (k == 0 ? WO_GU1 : WO_GU2)), MT, NGU, D}; pg8::StaticOrder S; S.init(MT, NGU, C.G, C.bid);
            pg8::EpiSwiGLU E{HID};
            pg8::gemm_phase<pg8::EpiSwiGLU, pg8::StaticOrder, true, true>(C.lds, g, S, E);
        } else if (k == 1 || k == 8) {
            pg8::Gemm g{HID, (const bf16*)(wl + (k == 1 ? WO_D1 : WO_D2)), MT, D, DFF}; pg8::StaticOrder S; S.init(MT, D, C.G, C.bid);
            pg8::EpiResid E{XB, YB, modl + (k == 1 ? 2 : 8) * D, 0.5f};
            pg8::gemm_phase<pg8::EpiResid, pg8::StaticOrder, true, true>(C.lds, g, S, E);
        } else if (k == 5) {
            pg8::Gemm g{YMIX, (const bf16*)(wl + WO_OUT), MT, D, D}; pg8::StaticOrder S; S.init(MT, D, C.G, C.bid);
            pg8::EpiResid E{XB, YB, modl + 5 * D, 1.0f};
            pg8::gemm_phase<pg8::EpiResid, pg8::StaticOrder, true, true>(C.lds, g, S, E);
        } else if (k == 3) {
            pg8::Gemm g{HB, (const bf16*)(wl + WO_IN), MT, DIN, D}; pg8::StaticOrder S; S.init(MT, DIN, C.G, C.bid);
            pg8::EpiBf16<0> E{PROJ, DIN, nullptr, 0, 0, 1.f};
            pg8::gemm_phase<pg8::EpiBf16<0>, pg8::StaticOrder, true, true>(C.lds, g, S, E);
        } else if (k == 4) {
            for (int u = C.bid; u < 256 + MS; u += C.G) { if (u < 256) mixer_prompt_tile(C, l, u); else mixer_sample(C, l, u - 256); }
        } else {
            const int li = k == 2 ? 0 : (k == 6 ? 1 : 2);
            const float* lg = C.ap->in[IN_LNG] + (size_t)(l * 3 + li) * D; const float* lb = C.ap->in[IN_LNB] + (size_t)(l * 3 + li) * D;
            if (k == 2) ln_phase(C, YB, true, lg, lb, XB, HB, modl + 3 * D, modl + 4 * D);
            else if (k == 6) ln_phase(C, YB, true, lg, lb, XB, HB, modl + 6 * D, modl + 7 * D);
            else if (l < DEPTH - 1) ln_phase(C, YB, true, lg, lb, XB, HB, modl + 9 * D, modl + 10 * D);
            else ln_phase(C, YB, true, lg, lb, C.out, nullptr, nullptr, nullptr);
        }
    }
}

extern "C" void kernel_launch(void* const* d_in, const int* in_sizes, int n_in, void* d_out, int out_size, void* d_ws, size_t ws_size, hipStream_t stream) {
    static int grid = 0;
    if (grid == 0) {
        if (n_in != 25 || ws_size < WS_END) { fprintf(stderr, "kernel_launch: need 25 inputs and %zu bytes of workspace; got %d, %zu\n", (size_t)WS_END, n_in, ws_size); grid = -1; return; }
        int dev = 0, cus = 0, per_cu = 0;
        if (hipGetDevice(&dev) != hipSuccess || hipDeviceGetAttribute(&cus, hipDeviceAttributeMultiprocessorCount, dev) != hipSuccess) { grid = -1; return; }
        if (hipFuncSetAttribute((const void*)fwd_kernel, hipFuncAttributeMaxDynamicSharedMemorySize, LDS_BYTES) != hipSuccess) { fprintf(stderr, "kernel_launch: hipFuncSetAttribute failed\n"); grid = -1; return; }
        if (hipOccupancyMaxActiveBlocksPerMultiprocessor(&per_cu, (const void*)fwd_kernel, NWAVES * 64, LDS_BYTES) != hipSuccess || per_cu < 1) { fprintf(stderr, "kernel_launch: occupancy query gave %d\n", per_cu); per_cu = 1; }
        (void)hipGetLastError();
        grid = cus * per_cu;
    }
    if (grid < 0) return;
    Args a{};
    for (int i = 0; i < 25; ++i) a.in[i] = (const float*)d_in[i];
    a.out = (float*)d_out; a.ws = (unsigned char*)d_ws;
#if MK_ONE_LAUNCH
    a.ph_lo = 0; a.ph_hi = NPH;
    void* kargs[] = {&a};
    hipError_t e = hipLaunchCooperativeKernel((const void*)fwd_kernel, dim3(grid), dim3(NWAVES * 64), kargs, LDS_BYTES, stream);
    if (e != hipSuccess) fprintf(stderr, "kernel_launch: cooperative launch failed: %s (grid %d)\n", hipGetErrorString(e), grid);
#else
    for (int ph = 0; ph < NPH; ++ph) {
        a.ph_lo = ph; a.ph_hi = ph + 1;
        hipLaunchKernelGGL(fwd_kernel, dim3(grid), dim3(NWAVES * 64), LDS_BYTES, stream, a);
    }
#endif
}
```

```cpp
#include <hip/hip_runtime.h>
#include <hip/hip_cooperative_groups.h>
#include <cstdio>
#include <cstdint>
namespace cg = cooperative_groups;
namespace pg8 {
#define PG8_LAS __attribute__((address_space(3)))
typedef unsigned short bf16_t;
typedef short bf16x8 __attribute__((ext_vector_type(8)));
typedef float f32x4 __attribute__((ext_vector_type(4)));
typedef unsigned u32x4 __attribute__((ext_vector_type(4)));
constexpr int BM = 256, BK = 64, HALF = 128, HTB = HALF * BK * 2  , STAGE_BYTES = 8 * HTB, NXCD = 8, WGM = 8;

__host__ __device__ __forceinline__ int lds_byte(int r, int c) { const int st = (r >> 4) * 2 + (c >> 5), rr = r & 15, cc = c & 31, ob = rr * 64 + cc * 2; return st * 1024 + (ob ^ (((ob >> 9) & 1) << 5)); }
__host__ __device__ __forceinline__ void stage_rc(int b, int& R, int& C) { const int st = b / 1024, sb = b % 1024, swz = sb ^ (((sb >> 9) & 1) << 5); R = (st >> 1) * 16 + swz / 64; C = (st & 1) * 32 + (swz % 64) / 2; }
__host__ __device__ __forceinline__ int perm32(int rho) { const int n = rho >> 4, i = rho & 15; return 8 * (i >> 2) + 4 * n + (i & 3); }

struct Unit { int pm, pn; };
struct Gemm { const bf16_t* A; const bf16_t* Bt; int M, N, K; };

struct StaticOrder {
    int nM, nN, nwg, G, c;
    __host__ __device__ void init(int M, int N, int G_, int c_) { nM = M / BM; nN = N / BM; nwg = nM * nN; G = G_; c = c_; }
    __host__ __device__ bool next(int i, Unit& u) const {
        const long L = (long)i * G + c; if (L >= nwg) return false;
        int wgid = (int)L; { const int q = nwg / NXCD, r = nwg % NXCD, xcd = wgid % NXCD, off = wgid / NXCD; wgid = (xcd < r ? xcd * (q + 1) : r * (q + 1) + (xcd - r) * q) + off; }
        const int nig = WGM * nN, gid = wgid / nig, fm = gid * WGM, gsz = (nM - fm) < WGM ? (nM - fm) : WGM;
        u.pm = fm + ((wgid % nig) % gsz); u.pn = (wgid % nig) / gsz; return true;
    }
    __device__ __forceinline__ void a_ready(const Unit&) const {}
    __device__ __forceinline__ void done(const Unit&) const {}
};

__device__ __forceinline__ unsigned cvt_pk_bf16(float lo, float hi) { unsigned r; asm volatile("v_cvt_pk_bf16_f32 %0, %1, %2" : "=v"(r) : "v"(lo), "v"(hi)); return r; }
typedef float f32x2 __attribute__((ext_vector_type(2)));
__device__ __forceinline__ f32x2 gelu_pk(f32x2 v) {
    const f32x2 av = __builtin_elementwise_abs(v), d = av * 0.2316418882f + 1.0f;
    f32x2 t; t.x = __builtin_amdgcn_rcpf(d.x); t.y = __builtin_amdgcn_rcpf(d.y);
    f32x2 q = t * 0.5307027145f + (-0.7265760135f); q = q * t + 0.7107068705f; q = q * t + (-0.142248368f); q = q * t + 0.127414796f; q = q * t;
    const f32x2 s = (v * v) * (-0.72134752044f);
    f32x2 e; e.x = __builtin_amdgcn_exp2f(s.x); e.y = __builtin_amdgcn_exp2f(s.y);
    const f32x2 m = v * (q * e), r = v - m;
    f32x2 o; o.x = v.x < 0.f ? m.x : r.x; o.y = v.y < 0.f ? m.y : r.y; return o;
}

template <int ACT  > struct EpiBf16 {
    static constexpr bool PERM = true, AFTER_DRAIN = false; static_assert(ACT == 0 || ACT == 1, "EpiBf16: ACT is 0 (none) or 1 (gelu_pk)");
    bf16_t* O; int ldc; const float* bias; int split_cols; size_t split_stride; float scale0;
    __device__ __forceinline__ void operator()(const f32x4 (&acc)[2][2][4][2], const Unit& u, int wr, int wc, int fr, int fq) const {
        const int row0 = u.pm * BM + wr * 64 + fr; int colt = u.pn * BM; bf16_t* base = O;
        float sc = 1.f; if (split_cols) { const int t = colt / split_cols; base += (size_t)t * split_stride; colt -= t * split_cols; if (t == 0) sc = scale0; }
        const int col0 = colt + wc * 32 + 8 * fq, bcol0 = u.pn * BM + wc * 32 + 8 * fq;
        f32x4 bv[2][2];
#pragma unroll
        for (int bj = 0; bj < 2; ++bj)
#pragma unroll
            for (int n = 0; n < 2; ++n) bv[bj][n] = bias ? *(const f32x4*)(bias + bcol0 + bj * HALF + 4 * n) : (f32x4){0.f, 0.f, 0.f, 0.f};
#pragma unroll
        for (int ai = 0; ai < 2; ++ai)
#pragma unroll
            for (int m = 0; m < 4; ++m) { bf16_t* rowp = base + (size_t)(row0 + ai * HALF + m * 16) * ldc + col0;
#pragma unroll
                for (int bj = 0; bj < 2; ++bj) { f32x4 v0 = acc[ai][bj][m][0] + bv[bj][0], v1 = acc[ai][bj][m][1] + bv[bj][1];
                    if (ACT == 1) { f32x2 a = gelu_pk((f32x2){v0[0], v0[1]}), b = gelu_pk((f32x2){v0[2], v0[3]}), c = gelu_pk((f32x2){v1[0], v1[1]}), d = gelu_pk((f32x2){v1[2], v1[3]});
                        v0 = (f32x4){a.x, a.y, b.x, b.y}; v1 = (f32x4){c.x, c.y, d.x, d.y}; }
                    v0 = v0 * sc; v1 = v1 * sc; u32x4 w; w.x = cvt_pk_bf16(v0[0], v0[1]); w.y = cvt_pk_bf16(v0[2], v0[3]); w.z = cvt_pk_bf16(v1[0], v1[1]); w.w = cvt_pk_bf16(v1[2], v1[3]);
                    *(u32x4*)(rowp + bj * HALF) = w; } }
    }
};

struct PanelStats {
    unsigned* xbuf;
    unsigned* cnt;
    unsigned* tmo;
    int ntn; float eps;
    unsigned code;
    __device__ __forceinline__ bool run(const f32x4 (&v)[2][2][4][2], const Unit& u, int wr, int wc, int fr, int fq, PG8_LAS unsigned char* lds, int wid, int lane) const {
        typedef float f32x2v __attribute__((ext_vector_type(2)));
        PG8_LAS f32x2v* P = (PG8_LAS f32x2v*)lds;
        PG8_LAS f32x2v* S = (PG8_LAS f32x2v*)(lds + 8192);
        PG8_LAS unsigned* flag = (PG8_LAS unsigned*)(lds + 8192 + 2048);
#pragma unroll
        for (int ai = 0; ai < 2; ++ai)
#pragma unroll
            for (int m = 0; m < 4; ++m) {
                float s = 0.f;
#pragma unroll
                for (int bj = 0; bj < 2; ++bj)
#pragma unroll
                    for (int n = 0; n < 2; ++n) { const f32x4 x = v[ai][bj][m][n]; s += (x[0] + x[1]) + (x[2] + x[3]); }
                s += __shfl_xor(s, 16); s += __shfl_xor(s, 32);
                const float mw = s * (1.0f / 64.0f); float q = 0.f;
#pragma unroll
                for (int bj = 0; bj < 2; ++bj)
#pragma unroll
                    for (int n = 0; n < 2; ++n) { const f32x4 d = v[ai][bj][m][n] - mw; q += (d[0] * d[0] + d[1] * d[1]) + (d[2] * d[2] + d[3] * d[3]); }
                q += __shfl_xor(q, 16); q += __shfl_xor(q, 32);
                if (fq == 0) P[(ai * HALF + wr * 64 + m * 16 + fr) * 4 + wc] = (f32x2v){mw, q};
            }
        asm volatile("s_waitcnt lgkmcnt(0)" ::: "memory"); __builtin_amdgcn_s_barrier(); asm volatile("" ::: "memory");
#if defined(BROKEN_EXCHANGE_NO_WAIT)
#warning BROKEN CONTROL BUILD: the row-statistics exchange does not wait; results are wrong by design
        if (blockIdx.x >= 64) { const long long t0_ = clock64(); while (clock64() - t0_ < 60000) __builtin_amdgcn_s_sleep(8); }
#endif
        const int row = wid * 32 + (lane & 31);
        if (lane < 32) {
            const f32x2v a = P[row * 4 + 0], b = P[row * 4 + 1], c = P[row * 4 + 2], d = P[row * 4 + 3];
            const float mt = (a.x + b.x + c.x + d.x) * 0.25f;
            const float da = a.x - mt, db = b.x - mt, dc = c.x - mt, dd = d.x - mt;
            const float m2 = (a.y + b.y) + (c.y + d.y) + 64.0f * ((da * da + db * db) + (dc * dc + dd * dd));
            unsigned long long* slot = (unsigned long long*)xbuf + ((size_t)(u.pm * BM + row) * 4 + u.pn);
            __hip_atomic_store(slot, ((unsigned long long)__float_as_uint(m2) << 32) | __float_as_uint(mt), __ATOMIC_RELAXED, __HIP_MEMORY_SCOPE_AGENT);
        }
        asm volatile("s_waitcnt vmcnt(0)" ::: "memory");
        if (lane == 0) __hip_atomic_fetch_add(cnt + 64 * u.pm, 1u, __ATOMIC_RELAXED, __HIP_MEMORY_SCOPE_AGENT);
        if (wid == 0) {
            bool dead = false; const unsigned long long t0 = __builtin_amdgcn_s_memrealtime(); const unsigned want = 8u * (unsigned)ntn;
            for (;;) {
#if defined(BROKEN_EXCHANGE_NO_WAIT)
                break;
#endif
                if ((unsigned)__builtin_amdgcn_readfirstlane(__hip_atomic_load(cnt + 64 * u.pm, __ATOMIC_RELAXED, __HIP_MEMORY_SCOPE_AGENT)) >= want) break;
                if (__builtin_amdgcn_s_memrealtime() - t0 > 2000000ull) {
                    if (lane == 0) { unsigned expect = 0u; __hip_atomic_compare_exchange_strong(tmo + 1, &expect, code | (unsigned)(u.pm & 0xff), __ATOMIC_RELAXED, __ATOMIC_RELAXED, __HIP_MEMORY_SCOPE_AGENT);
                                     __hip_atomic_store(tmo, 1u, __ATOMIC_RELAXED, __HIP_MEMORY_SCOPE_AGENT); }
                    dead = true; break; }
                __builtin_amdgcn_s_sleep(2);
            }
            __builtin_amdgcn_fence(__ATOMIC_ACQUIRE, "agent");
            if (lane == 0) flag[0] = dead ? 1u : 0u;
        }
        asm volatile("s_waitcnt vmcnt(0) lgkmcnt(0)" ::: "memory"); __builtin_amdgcn_s_barrier(); asm volatile("" ::: "memory");
        const bool bad = flag[0] != 0u;
        if (lane < 32) {
            const unsigned long long* slot = (const unsigned long long*)xbuf + (size_t)(u.pm * BM + row) * 4; float mt[4], m2[4]; float ms = 0.f;
#pragma unroll
            for (int t = 0; t < 4; ++t) { if (t < ntn) { const unsigned long long w = __hip_atomic_load(slot + t, __ATOMIC_RELAXED, __HIP_MEMORY_SCOPE_AGENT); mt[t] = __uint_as_float((unsigned)w); m2[t] = __uint_as_float((unsigned)(w >> 32)); } else { mt[t] = 0.f; m2[t] = 0.f; } ms += mt[t]; }
            const float mean = ms / (float)ntn; float q = 0.f;
#pragma unroll
            for (int t = 0; t < 4; ++t) if (t < ntn) { const float dm = mt[t] - mean; q += m2[t] + 256.0f * dm * dm; }
            S[row] = (f32x2v){mean, 1.0f / sqrtf(q / (256.0f * (float)ntn) + eps)};
        }
        asm volatile("s_waitcnt lgkmcnt(0)" ::: "memory"); __builtin_amdgcn_s_barrier(); asm volatile("" ::: "memory");
        return bad;
    }
};
struct EpiLnRes {
    static constexpr bool PERM = false, AFTER_DRAIN = true;
    const float* base; float* out; int ldc; const float* bias; PanelStats st; unsigned poison;
    __device__ __forceinline__ void fused(f32x4 (&acc)[2][2][4][2], const Unit& u, int wr, int wc, int fr, int fq, PG8_LAS unsigned char* lds, int wid, int lane) const {
        typedef float f32x2v __attribute__((ext_vector_type(2)));
        const PG8_LAS f32x2v* S = (const PG8_LAS f32x2v*)(lds + 8192);
        const int col0 = u.pn * BM + wc * 32 + 4 * fq;
#pragma unroll
        for (int bj = 0; bj < 2; ++bj)
#pragma unroll
            for (int n = 0; n < 2; ++n) { const f32x4 bv = bias ? *(const f32x4*)(bias + col0 + bj * HALF + n * 16) : (f32x4){0.f, 0.f, 0.f, 0.f};
#pragma unroll
                for (int ai = 0; ai < 2; ++ai)
#pragma unroll
                    for (int m = 0; m < 4; ++m) acc[ai][bj][m][n] += bv; }
        f32x4 pre[4][2][2];
#pragma unroll
        for (int m = 0; m < 4; ++m) { const size_t off = (size_t)(u.pm * BM + wr * 64 + m * 16 + fr) * ldc + col0;
#pragma unroll
            for (int bj = 0; bj < 2; ++bj)
#pragma unroll
                for (int n = 0; n < 2; ++n) pre[m][bj][n] = *(const f32x4*)(base + off + bj * HALF + n * 16); }
        const bool bad = st.run(acc, u, wr, wc, fr, fq, lds, wid, lane) || poison != 0u;
        const float qnan = __builtin_nanf("");
#pragma unroll
        for (int ai = 0; ai < 2; ++ai)
#pragma unroll
            for (int m = 0; m < 4; ++m) { const int r = ai * HALF + wr * 64 + m * 16 + fr; const f32x2v sr = S[r]; const size_t off = (size_t)(u.pm * BM + r) * ldc + col0;
#pragma unroll
                for (int bj = 0; bj < 2; ++bj)
#pragma unroll
                    for (int n = 0; n < 2; ++n) { const f32x4 bs = ai == 0 ? pre[m][bj][n] : *(const f32x4*)(base + off + bj * HALF + n * 16); f32x4 o = bs + (acc[ai][bj][m][n] - sr.x) * sr.y;
                        if (bad) o = (f32x4){qnan, qnan, qnan, qnan}; *(f32x4*)(out + off + bj * HALF + n * 16) = o; }
                if (m & 1) asm volatile("" ::: "memory"); }
    }
};
struct EpiLnResLn {
    static constexpr bool PERM = false, AFTER_DRAIN = true;
    const float* base; float* out; bf16_t* xn; int ldc; const float* bias; PanelStats st1, st2; unsigned poison;
    __device__ __forceinline__ void fused(f32x4 (&acc)[2][2][4][2], const Unit& u, int wr, int wc, int fr, int fq, PG8_LAS unsigned char* lds, int wid, int lane) const {
        typedef float f32x2v __attribute__((ext_vector_type(2))); typedef unsigned u32x2v __attribute__((ext_vector_type(2)));
        const PG8_LAS f32x2v* S = (const PG8_LAS f32x2v*)(lds + 8192);
        const int col0 = u.pn * BM + wc * 32 + 4 * fq;
#pragma unroll
        for (int bj = 0; bj < 2; ++bj)
#pragma unroll
            for (int n = 0; n < 2; ++n) { const f32x4 bv = bias ? *(const f32x4*)(bias + col0 + bj * HALF + n * 16) : (f32x4){0.f, 0.f, 0.f, 0.f};
#pragma unroll
                for (int ai = 0; ai < 2; ++ai)
#pragma unroll
                    for (int m = 0; m < 4; ++m) acc[ai][bj][m][n] += bv; }
        bool bad = st1.run(acc, u, wr, wc, fr, fq, lds, wid, lane) || poison != 0u;
        const float qnan = __builtin_nanf("");
#pragma unroll
        for (int ai = 0; ai < 2; ++ai)
#pragma unroll
            for (int m = 0; m < 4; ++m) { const int r = ai * HALF + wr * 64 + m * 16 + fr; const f32x2v sr = S[r]; const size_t off = (size_t)(u.pm * BM + r) * ldc + col0;
#pragma unroll
                for (int bj = 0; bj < 2; ++bj)
#pragma unroll
                    for (int n = 0; n < 2; ++n) { const f32x4 bs = *(const f32x4*)(base + off + bj * HALF + n * 16); acc[ai][bj][m][n] = bs + (acc[ai][bj][m][n] - sr.x) * sr.y; }
                asm volatile("" : "+v"(acc[ai][0][m][0]), "+v"(acc[ai][0][m][1]), "+v"(acc[ai][1][m][0]), "+v"(acc[ai][1][m][1]));
                if (m & 1) asm volatile("" ::: "memory"); }
        const bool bad1 = bad;
        bad = st2.run(acc, u, wr, wc, fr, fq, lds, wid, lane) || bad;
#pragma unroll
        for (int ai = 0; ai < 2; ++ai)
#pragma unroll
            for (int m = 0; m < 4; ++m) { const int r = ai * HALF + wr * 64 + m * 16 + fr; const f32x2v sr = S[r]; const size_t off = (size_t)(u.pm * BM + r) * ldc + col0;
#pragma unroll
                for (int bj = 0; bj < 2; ++bj)
#pragma unroll
                    for (int n = 0; n < 2; ++n) { const f32x4 x1 = acc[ai][bj][m][n]; *(f32x4*)(out + off + bj * HALF + n * 16) = bad1 ? (f32x4){qnan, qnan, qnan, qnan} : x1;
                        const f32x4 o = (x1 - sr.x) * sr.y; u32x2v w; w.x = cvt_pk_bf16(o[0], o[1]); w.y = cvt_pk_bf16(o[2], o[3]);
                        if (bad) { w.x = 0x7fc07fc0u; w.y = 0x7fc07fc0u; } *(u32x2v*)(xn + off + bj * HALF + n * 16) = w; }
                asm volatile("" ::: "memory"); }
    }
};

template <class Epi, class Sched, bool ALIGN_EPI = false, bool SP2 = false>
__device__ __forceinline__ void gemm_phase(PG8_LAS unsigned char* lds, const Gemm g, const Sched& S, const Epi& E) {
    int tid = threadIdx.x; asm volatile("" : "+v"(tid));
    const int wid = __builtin_amdgcn_readfirstlane(tid >> 6), lane = tid & 63, wr = wid >> 2, wc = wid & 3, fr = lane & 15, fq = lane >> 4;
    const int K = g.K, nt = K / BK;
    unsigned voffA[2], voffB[2];
#pragma unroll
    for (int i = 0; i < 2; ++i) { int R, C; stage_rc(tid * 16 + i * 8192, R, C); const int Rb = Epi::PERM ? ((R & ~31) + perm32(R & 31)) : R;
        voffA[i] = (unsigned)(R * K + C) * 2u; voffB[i] = (unsigned)(Rb * K + C) * 2u; }
    const size_t kstep = (size_t)(BK * 2);
    const size_t hstep = (size_t)HALF * K * 2;
    const size_t tstep = 2 * hstep;
    const unsigned ldsw = (unsigned)wid * 1024u;
    const int aoff = lds_byte(wr * 64 + fr, fq * 8), boff = lds_byte(wc * 32 + fr, fq * 8);
#define PG8_SA(b, h) (((b) * 2 + (h)) * HTB)
#define PG8_SB(b, h) ((4 + (b) * 2 + (h)) * HTB)
#define PG8_STAGE(bufoff, gbase, voff) do { _Pragma("unroll") for (int _i = 0; _i < 2; ++_i) \
        __builtin_amdgcn_global_load_lds((const unsigned*)((const char*)(gbase) + (voff)[_i]), (PG8_LAS unsigned*)(lds + (bufoff) + ldsw + _i * 8192), 16, 0, 0); } while (0)
#define PG8_LDA(dst, b, h) do { _Pragma("unroll") for (int m = 0; m < 4; ++m) _Pragma("unroll") for (int k = 0; k < 2; ++k) dst[m][k] = *(const PG8_LAS bf16x8*)(lds + PG8_SA(b, h) + aoff + m * 2048 + k * 1024); } while (0)
#define PG8_LDB(dst, b, h) do { _Pragma("unroll") for (int n = 0; n < 2; ++n) _Pragma("unroll") for (int k = 0; k < 2; ++k) dst[n][k] = *(const PG8_LAS bf16x8*)(lds + PG8_SB(b, h) + boff + n * 2048 + k * 1024); } while (0)
#define PG8_MMA(ai, bj, At, Bt) do { __builtin_amdgcn_s_setprio(1); _Pragma("unroll") for (int m = 0; m < 4; ++m) _Pragma("unroll") for (int n = 0; n < 2; ++n) _Pragma("unroll") for (int k = 0; k < 2; ++k) \
        acc[ai][bj][m][n] = __builtin_amdgcn_mfma_f32_16x16x32_bf16(Bt[n][k], At[m][k], acc[ai][bj][m][n], 0, 0, 0); __builtin_amdgcn_s_setprio(0); } while (0)
#define PG8_WAIT_V(n) asm volatile("s_waitcnt vmcnt(" #n ")" ::: "memory")
#define PG8_WAIT_L(n) asm volatile("s_waitcnt lgkmcnt(" #n ")" ::: "memory")
#define PG8_BAR __builtin_amdgcn_s_barrier()
#define PG8_SCHED __builtin_amdgcn_sched_barrier(0)
    Unit cur, nxt; int ui = 0;
    if (!S.next(0, cur)) return;
    f32x4 acc[2][2][4][2];
#pragma unroll
    for (int a = 0; a < 2; ++a)
#pragma unroll
        for (int b = 0; b < 2; ++b)
#pragma unroll
            for (int m = 0; m < 4; ++m)
#pragma unroll
                for (int n = 0; n < 2; ++n) acc[a][b][m][n] = (f32x4){0.f, 0.f, 0.f, 0.f};
    bf16x8 At[4][2], B0[2][2], B1[2][2];
    const char* cA = (const char*)g.A + (size_t)cur.pm * tstep; const char* cB = (const char*)g.Bt + (size_t)cur.pn * tstep;
    S.a_ready(cur);
    if constexpr (SP2) {
        PG8_STAGE(PG8_SB(0, 0), cB, voffB); PG8_STAGE(PG8_SB(0, 1), cB + hstep, voffB); PG8_STAGE(PG8_SA(0, 0), cA, voffA); PG8_STAGE(PG8_SA(0, 1), cA + hstep, voffA);
        if (wr == 1) PG8_BAR;
        PG8_WAIT_V(2); PG8_BAR;
        PG8_STAGE(PG8_SB(1, 0), cB + kstep, voffB); PG8_STAGE(PG8_SA(1, 0), cA + kstep, voffA); PG8_STAGE(PG8_SB(1, 1), cB + hstep + kstep, voffB);
        PG8_WAIT_V(6); PG8_BAR;
    } else {
        PG8_STAGE(PG8_SB(0, 0), cB, voffB); PG8_STAGE(PG8_SA(0, 0), cA, voffA); PG8_STAGE(PG8_SB(0, 1), cB + hstep, voffB); PG8_STAGE(PG8_SA(0, 1), cA + hstep, voffA);
        if (wr == 1) PG8_BAR;
        PG8_WAIT_V(4); PG8_BAR;
        PG8_STAGE(PG8_SB(1, 0), cB + kstep, voffB); PG8_STAGE(PG8_SA(1, 0), cA + kstep, voffA); PG8_STAGE(PG8_SB(1, 1), cB + hstep + kstep, voffB);
        PG8_WAIT_V(6); PG8_BAR;
    }
    for (;;) {
        const bool has_next = S.next(ui + 1, nxt);
        const char* nA = has_next ? (const char*)g.A + (size_t)nxt.pm * tstep : cA; const char* nB = has_next ? (const char*)g.Bt + (size_t)nxt.pn * tstep : cB;
        for (int t = 0; t < nt; t += 2) {
            const bool last = (t == nt - 2);
            const char* a1 = cA + (size_t)(t + 1) * kstep;
            const char* a2 = last ? nA : cA + (size_t)(t + 2) * kstep; const char* b2 = last ? nB : cB + (size_t)(t + 2) * kstep;
            const char* a3 = a2 + kstep; const char* b3 = b2 + kstep;
            if (last && has_next) S.a_ready(nxt);
            if constexpr (SP2) {
            PG8_LDB(B0, 0, 0); PG8_LDB(B1, 0, 1); PG8_SCHED; PG8_LDA(At, 0, 0); PG8_STAGE(PG8_SA(1, 1), a1 + hstep, voffA);
            PG8_WAIT_V(8); PG8_WAIT_L(0); PG8_BAR; PG8_MMA(0, 0, At, B0); PG8_MMA(0, 1, At, B1); PG8_BAR; PG8_SCHED;
            PG8_LDA(At, 0, 1); PG8_STAGE(PG8_SB(0, 0), b2, voffB); PG8_STAGE(PG8_SB(0, 1), b2 + hstep, voffB); PG8_STAGE(PG8_SA(0, 0), a2, voffA);
            PG8_WAIT_V(8); PG8_WAIT_L(0); PG8_BAR; PG8_MMA(1, 0, At, B0); PG8_MMA(1, 1, At, B1); PG8_BAR; PG8_SCHED;
            PG8_LDB(B0, 1, 0); PG8_LDB(B1, 1, 1); PG8_SCHED; PG8_LDA(At, 1, 0); PG8_STAGE(PG8_SA(0, 1), a2 + hstep, voffA);
            PG8_WAIT_V(8); PG8_WAIT_L(0); PG8_BAR; PG8_MMA(0, 0, At, B0); PG8_MMA(0, 1, At, B1); PG8_BAR; PG8_SCHED;
            PG8_LDA(At, 1, 1); PG8_STAGE(PG8_SB(1, 0), b3, voffB); PG8_STAGE(PG8_SB(1, 1), b3 + hstep, voffB); PG8_STAGE(PG8_SA(1, 0), a3, voffA);
            PG8_WAIT_V(8); PG8_WAIT_L(0); PG8_BAR; PG8_MMA(1, 0, At, B0); PG8_MMA(1, 1, At, B1); PG8_BAR; PG8_SCHED;
            } else {
            PG8_LDB(B0, 0, 0); PG8_SCHED; PG8_LDA(At, 0, 0); PG8_STAGE(PG8_SA(1, 1), a1 + hstep, voffA);
            PG8_WAIT_L(8); PG8_BAR; PG8_WAIT_L(0); PG8_MMA(0, 0, At, B0); PG8_BAR; PG8_SCHED;
            PG8_LDB(B1, 0, 1); PG8_STAGE(PG8_SB(0, 0), b2, voffB);
            PG8_BAR; PG8_WAIT_L(0); PG8_MMA(0, 1, At, B1); PG8_BAR;
            PG8_LDA(At, 0, 1); PG8_STAGE(PG8_SA(0, 0), a2, voffA);
            PG8_BAR; PG8_WAIT_L(0); PG8_MMA(1, 0, At, B0); PG8_BAR; PG8_SCHED;
            PG8_STAGE(PG8_SB(0, 1), b2 + hstep, voffB);
            PG8_WAIT_V(6); PG8_BAR; PG8_MMA(1, 1, At, B1); PG8_BAR;
            PG8_LDB(B0, 1, 0); PG8_SCHED; PG8_LDA(At, 1, 0); PG8_STAGE(PG8_SA(0, 1), a2 + hstep, voffA);
            PG8_WAIT_L(8); PG8_BAR; PG8_WAIT_L(0); PG8_MMA(0, 0, At, B0); PG8_BAR; PG8_SCHED;
            PG8_LDB(B1, 1, 1); PG8_STAGE(PG8_SB(1, 0), b3, voffB);
            PG8_BAR; PG8_WAIT_L(0); PG8_MMA(0, 1, At, B1); PG8_BAR;
            PG8_LDA(At, 1, 1); PG8_STAGE(PG8_SA(1, 0), a3, voffA);
            PG8_BAR; PG8_WAIT_L(0); PG8_MMA(1, 0, At, B0); PG8_BAR; PG8_SCHED;
            PG8_STAGE(PG8_SB(1, 1), b3 + hstep, voffB);
            PG8_WAIT_V(6); PG8_BAR; PG8_MMA(1, 1, At, B1); PG8_BAR;
            }
        }
        if constexpr (ALIGN_EPI) { if (wr == 0) PG8_BAR; }
        if constexpr (!Epi::AFTER_DRAIN) { E(acc, cur, wr, wc, fr, fq); S.done(cur); }
        if (!has_next) break;
#pragma unroll
        for (int a = 0; a < 2; ++a)
#pragma unroll
            for (int b = 0; b < 2; ++b)
#pragma unroll
                for (int m = 0; m < 4; ++m)
#pragma unroll
                    for (int n = 0; n < 2; ++n) acc[a][b][m][n] = (f32x4){0.f, 0.f, 0.f, 0.f};
        cur = nxt; cA = nA; cB = nB; ++ui;
        if constexpr (ALIGN_EPI) { if (wr == 1) PG8_BAR; }
    }
    PG8_WAIT_V(0);
    if constexpr (!ALIGN_EPI) { if (wr == 0) PG8_BAR; }
    PG8_BAR;
    if constexpr (Epi::AFTER_DRAIN) { E.fused(acc, cur, wr, wc, fr, fq, lds, wid, lane); S.done(cur); }
#undef PG8_SA
#undef PG8_SB
#undef PG8_STAGE
#undef PG8_LDA
#undef PG8_LDB
#undef PG8_MMA
#undef PG8_WAIT_V
#undef PG8_WAIT_L
#undef PG8_BAR
#undef PG8_SCHED
}
}

#ifndef MK_ONE_LAUNCH
#define MK_ONE_LAUNCH 1
#endif
constexpr int D = 1024, DFF = 2816, DIN = 1792, DEPTH = 4, SEQ = 8192;
constexpr int MP = 16384, MS = 128, MV = MP + MS, MT = 16640;
constexpr int NGU = 2 * DFF;
constexpr int NMODC = 4 * 9 * D;
constexpr int NBATCH = 130;
constexpr float ALPHA = 1.6817928305074290f;
constexpr float LN_EPS = 1e-5f, RMS_EPS = 1e-6f;
constexpr int NPH = 3 + 10 * DEPTH;
constexpr size_t O_YP = 0, O_YS = 16777216, O_PC = 16908288, O_PP = 16912384, O_PK = 16943104, O_PV = 17074176, O_SC = 17205248, O_SP = 17467392, O_SK = 19433472, O_SV = 27822080;
constexpr size_t WL_BYTES = 40370176;
constexpr size_t WO_GU1 = 0, WO_D1 = 11534336, WO_IN = 17301504, WO_OUT = 20971520, WO_GU2 = 23068672, WO_D2 = 34603008;
constexpr size_t WS_W = 1048576;
constexpr size_t WS_POOLW = WS_W + 4 * WL_BYTES;
constexpr size_t WS_AC = WS_POOLW + 131072;
constexpr size_t WS_MOD = WS_AC + 524288;
constexpr size_t WS_XB = WS_MOD + (size_t)NBATCH * NMODC * 4;
constexpr size_t WS_YB = WS_XB + (size_t)MT * D * 4;
constexpr size_t WS_HB = WS_YB + (size_t)MT * D * 4;
constexpr size_t WS_HID = WS_HB + (size_t)MT * D * 2;
constexpr size_t WS_PROJ = WS_HID + (size_t)MT * DFF * 2;
constexpr size_t WS_YMIX = WS_PROJ + (size_t)MT * DIN * 2;
constexpr size_t WS_END = WS_YMIX + (size_t)MT * D * 2;
static_assert((size_t)NMODC * D * 2 <= (size_t)MT * DFF * 2, "w_ada copy fits the hidden buffer");
static_assert(WS_END < 600000000ull, "workspace");
constexpr int LDS_BYTES = 147456, XB_ST_OFF = LDS_BYTES - 16;
constexpr int NWAVES = 8;

#define LAS __attribute__((address_space(3)))
typedef unsigned short bf16;
typedef unsigned u32x4 __attribute__((ext_vector_type(4)));
typedef unsigned u32x2 __attribute__((ext_vector_type(2)));
typedef float f32x4 __attribute__((ext_vector_type(4)));
typedef short bf16x8 __attribute__((ext_vector_type(8)));

__device__ __forceinline__ unsigned f2bf(float f) { unsigned u = __builtin_bit_cast(unsigned, f); return (u + 0x7fffu + ((u >> 16) & 1u)) >> 16; }
__device__ __forceinline__ unsigned pk2(float lo, float hi) { return f2bf(lo) | (f2bf(hi) << 16); }
__device__ __forceinline__ float bf2f(unsigned short u) { return __builtin_bit_cast(float, (unsigned)u << 16); }
__device__ __forceinline__ float wave_sum(float v) {
#pragma unroll
    for (int o = 1; o < 64; o <<= 1) v += __shfl_xor(v, o);
    return v;
}
__device__ __forceinline__ float wave_max(float v) {
#pragma unroll
    for (int o = 1; o < 64; o <<= 1) v = fmaxf(v, __shfl_xor(v, o));
    return v;
}
__device__ __forceinline__ float silu_f(float g) { return g * __builtin_amdgcn_rcpf(1.0f + __expf(-g)); }
__device__ __forceinline__ int batch_of_row(int r) { return r < SEQ ? 0 : (r < MP ? 1 : (r - MP + 2 < NBATCH ? r - MP + 2 : NBATCH - 1)); }

namespace pg8 {
struct EpiSwiGLU {
    static constexpr bool PERM = true, AFTER_DRAIN = false;
    bf16_t* H;
    __device__ __forceinline__ void operator()(const f32x4 (&acc)[2][2][4][2], const Unit& u, int wr, int wc, int fr, int fq) const {
        const int row0 = u.pm * BM + wr * 64 + fr, col0 = u.pn * 128 + wc * 32 + 8 * fq;
#pragma unroll
        for (int ai = 0; ai < 2; ++ai)
#pragma unroll
            for (int m = 0; m < 4; ++m) {
                bf16_t* rowp = H + (size_t)(row0 + ai * HALF + m * 16) * DFF + col0;
                const f32x4 g0 = acc[ai][0][m][0], g1 = acc[ai][0][m][1], u0 = acc[ai][1][m][0], u1 = acc[ai][1][m][1];
                u32x4 w;
                w.x = cvt_pk_bf16(silu_f(g0[0]) * u0[0], silu_f(g0[1]) * u0[1]); w.y = cvt_pk_bf16(silu_f(g0[2]) * u0[2], silu_f(g0[3]) * u0[3]);
                w.z = cvt_pk_bf16(silu_f(g1[0]) * u1[0], silu_f(g1[1]) * u1[1]); w.w = cvt_pk_bf16(silu_f(g1[2]) * u1[2], silu_f(g1[3]) * u1[3]);
                *(u32x4*)rowp = w;
            }
    }
};
struct EpiResid {
    static constexpr bool PERM = false, AFTER_DRAIN = false;
    const float* x; float* y; const float* gate; float scale;
    __device__ __forceinline__ void operator()(const f32x4 (&acc)[2][2][4][2], const Unit& u, int wr, int wc, int fr, int fq) const {
        const int col0 = u.pn * BM + wc * 32 + 4 * fq;
#pragma unroll
        for (int ai = 0; ai < 2; ++ai)
#pragma unroll
            for (int m = 0; m < 4; ++m) {
                const int r = u.pm * BM + ai * HALF + wr * 64 + m * 16 + fr;
                const float* gp = gate + (size_t)batch_of_row(r) * NMODC + col0;
                const size_t off = (size_t)r * D + col0;
#pragma unroll
                for (int bj = 0; bj < 2; ++bj)
#pragma unroll
                    for (int n = 0; n < 2; ++n) {
                        const f32x4 xv = *(const f32x4*)(x + off + bj * HALF + n * 16), gv = *(const f32x4*)(gp + bj * HALF + n * 16);
                        *(f32x4*)(y + off + bj * HALF + n * 16) = xv * ALPHA + gv * scale * acc[ai][bj][m][n];
                    }
            }
    }
};
struct EpiMod {
    static constexpr bool PERM = false, AFTER_DRAIN = false;
    float* out; const float* bias;
    __device__ __forceinline__ void operator()(const f32x4 (&acc)[2][2][4][2], const Unit& u, int wr, int wc, int fr, int fq) const {
        const int col0 = u.pn * BM + wc * 32 + 4 * fq;
#pragma unroll
        for (int ai = 0; ai < 2; ++ai)
#pragma unroll
            for (int m = 0; m < 4; ++m) {
                const int r = ai * HALF + wr * 64 + m * 16 + fr;
                if (r < NBATCH) {
#pragma unroll
                    for (int bj = 0; bj < 2; ++bj)
#pragma unroll
                        for (int n = 0; n < 2; ++n) {
                            const int c = col0 + bj * HALF + n * 16;
                            *(f32x4*)(out + (size_t)r * NMODC + c) = acc[ai][bj][m][n] + *(const f32x4*)(bias + c);
                        }
                }
            }
    }
};
}

struct Args { const float* in[25]; float* out; unsigned char* ws; int ph_lo, ph_hi; };
typedef const __attribute__((address_space(4))) Args* kargs_t;
struct Ctx {
    kargs_t ap;
    float* out; unsigned char* ws;
    LAS unsigned char* lds;
    int tid, lane, wave, G, bid;
};
#define IN_XP 0
#define IN_XS 1
#define IN_SCONV 2
#define IN_SPOOL 3
#define IN_CK 4
#define IN_CV 5
#define IN_CP 6
#define IN_CS 7
#define IN_LNG 8
#define IN_LNB 9
#define IN_WADA 10
#define IN_BADA 11
#define IN_F1G 12
#define IN_F1U 13
#define IN_F1D 14
#define IN_WIN 15
#define IN_CONVW 16
#define IN_POOLW 17
#define IN_PSCALE 18
#define IN_SINKS 19
#define IN_MIXG 20
#define IN_WOUT 21
#define IN_F2G 22
#define IN_F2U 23
#define IN_F2D 24

__device__ __forceinline__ void transpose_item(const float* W, int K, int N, bf16* WT, int k0, int n0, int drow0, LAS float* scr, int lane) {
#pragma unroll 8
    for (int i = 0; i < 32; ++i) { const int kk = 2 * i + (lane >> 5); scr[kk * 33 + (lane & 31)] = W[(size_t)(k0 + kk) * N + n0 + (lane & 31)]; }
    asm volatile("s_waitcnt lgkmcnt(0)" ::: "memory");
    const int c = lane & 7;
#pragma unroll
    for (int j = 0; j < 4; ++j) { const int n = (lane >> 3) + 8 * j; const LAS float* s = scr + (8 * c) * 33 + n;
        u32x4 o; o.x = pk2(s[0 * 33], s[1 * 33]); o.y = pk2(s[2 * 33], s[3 * 33]); o.z = pk2(s[4 * 33], s[5 * 33]); o.w = pk2(s[6 * 33], s[7 * 33]);
        *(u32x4*)(WT + (size_t)(drow0 + n) * K + k0 + 8 * c) = o; }
    asm volatile("s_waitcnt lgkmcnt(0)" ::: "memory");
}
constexpr int IT_G = 1408, IT_IN = 896, IT_O = 512, IT_ADA = 4608, IT_LB = 6 * IT_G + IT_IN + IT_O + IT_ADA;
__device__ __forceinline__ void p0_prologue(const Ctx& C) {
    LAS float* scr = (LAS float*)(C.lds + C.wave * 16384);
    const int gw = C.bid * NWAVES + C.wave, NGW = C.G * NWAVES, lane = C.lane;
    unsigned char* ws = C.ws;
    const int NITEMS = DEPTH * IT_LB + 32;
    for (int it = gw; it < NITEMS; it += NGW) {
        const float* W; int K, N, mode = 0; bf16* WT; int r;
        if (it < DEPTH * IT_LB) {
            const int l = it / IT_LB; r = it % IT_LB;
            unsigned char* wl = ws + WS_W + (size_t)l * WL_BYTES;
            const size_t fo = (size_t)l * D * DFF;
            if (r < IT_G) { W = C.ap->in[IN_F1G] + fo; K = D; N = DFF; WT = (bf16*)(wl + WO_GU1); mode = 1; }
            else if ((r -= IT_G) < IT_G) { W = C.ap->in[IN_F1U] + fo; K = D; N = DFF; WT = (bf16*)(wl + WO_GU1); mode = 2; }
            else if ((r -= IT_G) < IT_G) { W = C.ap->in[IN_F1D] + fo; K = DFF; N = D; WT = (bf16*)(wl + WO_D1); }
            else if ((r -= IT_G) < IT_IN) { W = C.ap->in[IN_WIN] + (size_t)l * D * DIN; K = D; N = DIN; WT = (bf16*)(wl + WO_IN); }
            else if ((r -= IT_IN) < IT_O) { W = C.ap->in[IN_WOUT] + (size_t)l * D * D; K = D; N = D; WT = (bf16*)(wl + WO_OUT); }
            else if ((r -= IT_O) < IT_G) { W = C.ap->in[IN_F2G] + fo; K = D; N = DFF; WT = (bf16*)(wl + WO_GU2); mode = 1; }
            else if ((r -= IT_G) < IT_G) { W = C.ap->in[IN_F2U] + fo; K = D; N = DFF; WT = (bf16*)(wl + WO_GU2); mode = 2; }
            else if ((r -= IT_G) < IT_G) { W = C.ap->in[IN_F2D] + fo; K = DFF; N = D; WT = (bf16*)(wl + WO_D2); }
            else { r -= IT_G; W = C.ap->in[IN_WADA] + (size_t)l * D * 9 * D; K = D; N = 9 * D; WT = (bf16*)(ws + WS_HID) + (size_t)l * 9 * D * D; }
        } else {
            r = it - DEPTH * IT_LB; const int mat = r >> 1; r &= 1;
            W = C.ap->in[IN_POOLW] + (size_t)mat * 4096; K = 64; N = 64; WT = (bf16*)(ws + WS_POOLW) + (size_t)mat * 4096;
        }
        const int nblk = N / 32, kb = r / nblk, nb = r % nblk, n0 = 32 * nb;
        const int drow0 = mode == 0 ? n0 : (256 * (n0 >> 7) + (n0 & 127) + (mode == 2 ? 128 : 0));
        transpose_item(W, K, N, WT, 64 * kb, n0, drow0, scr, lane);
    }
    float* XB = (float*)(ws + WS_XB); bf16* HB = (bf16*)(ws + WS_HB); bf16* YM = (bf16*)(ws + WS_YMIX); bf16* AC = (bf16*)(ws + WS_AC);
    for (int j = gw; j < MT + 256; j += NGW) {
        if (j < MT) {
            const float* src = j < MP ? C.ap->in[IN_XP] + (size_t)j * D : (j < MV ? C.ap->in[IN_XS] + (size_t)(j - MP) * D : nullptr);
            f32x4* dst = (f32x4*)(XB + (size_t)j * D) + lane;
#pragma unroll
            for (int q = 0; q < 4; ++q) dst[64 * q] = src ? ((const f32x4*)src)[lane + 64 * q] : (f32x4){0.f, 0.f, 0.f, 0.f};
            if (j >= MV) {
                u32x4* h = (u32x4*)(HB + (size_t)j * D) + lane; u32x4* y = (u32x4*)(YM + (size_t)j * D) + lane;
                h[0] = (u32x4){0, 0, 0, 0}; h[64] = (u32x4){0, 0, 0, 0}; y[0] = (u32x4){0, 0, 0, 0}; y[64] = (u32x4){0, 0, 0, 0};
            }
        } else {
            const int r = j - MT;
            const float* src = r < 2 ? C.ap->in[IN_CP] + (size_t)r * D : (r < NBATCH ? C.ap->in[IN_CS] + (size_t)(r - 2) * D : nullptr);
            u32x2* dst = (u32x2*)(AC + (size_t)r * D) + lane;
#pragma unroll
            for (int q = 0; q < 4; ++q) {
                f32x4 v = src ? ((const f32x4*)src)[lane + 64 * q] : (f32x4){0.f, 0.f, 0.f, 0.f};
                u32x2 o; o.x = pk2(silu_f(v.x), silu_f(v.y)); o.y = pk2(silu_f(v.z), silu_f(v.w)); dst[64 * q] = o;
            }
        }
    }
}

__device__ __forceinline__ void ln_phase(const Ctx& C, const float* src, bool do_ln, const float* lg, const float* lb, float* xdst, bf16* hdst, const float* msh, const float* msc) {
    const int gw = C.bid * NWAVES + C.wave, NGW = C.G * NWAVES, lane = C.lane;
    for (int r = gw; r < MV; r += NGW) {
        const f32x4* xr = (const f32x4*)(src + (size_t)r * D) + lane;
        f32x4 v[4];
#pragma unroll
        for (int j = 0; j < 4; ++j) v[j] = xr[64 * j];
        if (do_ln) {
            float s = 0.f;
#pragma unroll
            for (int j = 0; j < 4; ++j) s += (v[j].x + v[j].y) + (v[j].z + v[j].w);
            const float mean = wave_sum(s) * (1.f / D); float s2 = 0.f;
#pragma unroll
            for (int j = 0; j < 4; ++j) { v[j] = v[j] - mean; s2 += (v[j].x * v[j].x + v[j].y * v[j].y) + (v[j].z * v[j].z + v[j].w * v[j].w); }
            const float rstd = 1.f / sqrtf(wave_sum(s2) * (1.f / D) + LN_EPS);
#pragma unroll
            for (int j = 0; j < 4; ++j) v[j] = v[j] * rstd * ((const f32x4*)lg)[lane + 64 * j] + ((const f32x4*)lb)[lane + 64 * j];
            if (xdst) { f32x4* xo = (f32x4*)(xdst + (size_t)r * D) + lane;
#pragma unroll
                for (int j = 0; j < 4; ++j) xo[64 * j] = v[j]; }
        }
        if (hdst) {
            const size_t mo = (size_t)batch_of_row(r) * NMODC;
            u32x2* ho = (u32x2*)(hdst + (size_t)r * D) + lane;
#pragma unroll
            for (int j = 0; j < 4; ++j) {
                const f32x4 sh = ((const f32x4*)(msh + mo))[lane + 64 * j], sc = ((const f32x4*)(msc + mo))[lane + 64 * j];
                const f32x4 h = v[j] * (sc + 1.0f) + sh;
                u32x2 o; o.x = pk2(h.x, h.y); o.y = pk2(h.z, h.w); ho[64 * j] = o;
            }
        }
    }
}

__device__ __forceinline__ void norm_rows256(LAS float* OUT, bf16* Y, const float* g, int wave, int lane) {
    const f32x4 gg = ((const f32x4*)g)[lane];
#pragma unroll
    for (int i = 0; i < 8; ++i) {
        const int row = wave * 8 + i;
        const f32x4 v = *(const LAS f32x4*)(OUT + row * 260 + lane * 4);
        const float ss = wave_sum((v.x * v.x + v.y * v.y) + (v.z * v.z + v.w * v.w));
        const float sc = 1.0f / sqrtf(ss * (1.f / 256.f) + RMS_EPS);
        u32x2 o; o.x = pk2(v.x * sc * gg.x, v.y * sc * gg.y); o.y = pk2(v.z * sc * gg.z, v.w * sc * gg.w);
        *(u32x2*)(Y + (size_t)row * D + lane * 4) = o;
    }
}

__device__ __forceinline__ void mixer_prompt_tile(const Ctx& C, int l, int tile) {
    const int tid = C.tid, wave = C.wave, lane = C.lane, fr = lane & 15, fq = lane >> 4;
    const int b = tile >> 7, t0 = (tile & 127) * 64;
    const bf16* P = (const bf16*)(C.ws + WS_PROJ) + (size_t)(b * SEQ) * DIN;
    bf16* Y = (bf16*)(C.ws + WS_YMIX) + (size_t)(b * SEQ + t0) * D;
    LAS unsigned char* lds = C.lds;
    LAS float* OUT = (LAS float*)lds;
    LAS bf16* UT = (LAS bf16*)(lds + 66560);
    LAS bf16* PL = (LAS bf16*)(lds + 66560 + 40448);
    const float* mixg = C.ap->in[IN_MIXG] + (size_t)l * D;
    __syncthreads();
    {
        const int c = tid & 255, half = tid >> 8, tb = t0 + half * 32;
        const float* cw = C.ap->in[IN_CONVW] + (size_t)l * 768;
        const float w0 = cw[c], w1 = cw[256 + c], w2 = cw[512 + c];
        float cm2 = 0.f, cm1 = 0.f;
        if (tb >= 2) { const bf16* p2 = P + (size_t)(tb - 2) * DIN; cm2 = bf2f(p2[256 + c]) * bf2f(p2[512 + c]); cm1 = bf2f(p2[DIN + 256 + c]) * bf2f(p2[DIN + 512 + c]); }
        float* pc = C.out + O_PC + (size_t)((l * 2 + b) * 2) * 256;
#pragma unroll 4
        for (int i = 0; i < 32; ++i) {
            const bf16* p = P + (size_t)(tb + i) * DIN;
            const float gb = bf2f(p[c]), cv = bf2f(p[256 + c]) * bf2f(p[512 + c]);
            OUT[(half * 32 + i) * 260 + c] = gb * (w0 * cm2 + w1 * cm1 + w2 * cv);
            if (tb + i >= SEQ - 2) pc[(tb + i - (SEQ - 2)) * 256 + c] = cv;
            cm2 = cm1; cm1 = cv;
        }
    }
    for (int ch = tid; ch < 79 * 32; ch += 512) {
        const int row = ch >> 5, cc = ch & 31, t = t0 - 15 + row;
        u32x4 v = (u32x4){0, 0, 0, 0};
        if (t >= 0) v = *(const u32x4*)(P + (size_t)t * DIN + 768 + cc * 8);
        *(LAS u32x4*)(UT + row * 256 + cc * 8) = v;
    }
    __syncthreads();
    norm_rows256(OUT, Y, mixg, wave, lane);
    {
        const int c = tid & 255, half = tid >> 8, g = c >> 6, w = 2 << g, r0 = 15 + half * 32;
        float s = 0.f;
        for (int j = 1; j < w; ++j) s += bf2f(UT[(r0 - j) * 256 + c]);
        float* pp = C.out + O_PP + (size_t)((l * 2 + b) * 15) * 256;
        for (int i = 0; i < 32; ++i) {
            const float uu = bf2f(UT[(r0 + i) * 256 + c]);
            s += uu;
            const int t = t0 + half * 32 + i;
            const float cnt = (float)(t + 1 < w ? t + 1 : w);
            PL[(half * 32 + i) * 264 + c] = (bf16)f2bf(s / cnt - uu);
            s -= bf2f(UT[(r0 + i - w + 1) * 256 + c]);
            if (t >= SEQ - 15) pp[(t - (SEQ - 15)) * 256 + c] = uu;
        }
    }
    __syncthreads();
    {
        const int g = wave >> 1, dbase = (wave & 1) * 2;
        const bf16* PW = (const bf16*)(C.ws + WS_POOLW) + (size_t)((l * 4 + g) * 64) * 64;
        const float* psc = C.ap->in[IN_PSCALE] + (size_t)l * 256;
        bf16x8 wf[2][2];
#pragma unroll
        for (int di = 0; di < 2; ++di)
#pragma unroll
            for (int kk = 0; kk < 2; ++kk) wf[di][kk] = *(const bf16x8*)(PW + (size_t)(16 * (dbase + di) + fr) * 64 + 32 * kk + 8 * fq);
#pragma unroll
        for (int tb = 0; tb < 4; ++tb) {
            const bf16x8 p0 = *(const LAS bf16x8*)(PL + (16 * tb + fr) * 264 + g * 64 + 8 * fq), p1 = *(const LAS bf16x8*)(PL + (16 * tb + fr) * 264 + g * 64 + 32 + 8 * fq);
#pragma unroll
            for (int di = 0; di < 2; ++di) {
                f32x4 a = (f32x4){0.f, 0.f, 0.f, 0.f};
                a = __builtin_amdgcn_mfma_f32_16x16x32_bf16(wf[di][0], p0, a, 0, 0, 0);
                a = __builtin_amdgcn_mfma_f32_16x16x32_bf16(wf[di][1], p1, a, 0, 0, 0);
                const int col = g * 64 + 16 * (dbase + di) + 4 * fq;
                *(LAS f32x4*)(OUT + (16 * tb + fr) * 260 + col) = a * *(const f32x4*)(psc + col);
            }
        }
    }
    __syncthreads();
    norm_rows256(OUT, Y + 256, mixg + 256, wave, lane);
    __syncthreads();
    {
        const int h = wave, kvh = h >> 2;
        LAS bf16* KS = (LAS bf16*)lds;
        LAS bf16* VT = (LAS bf16*)(lds + 52224);
        LAS float* SSQ = (LAS float*)(lds + 103424);
        for (int ch = tid; ch < 192 * 16; ch += 512) {
            const int key = ch >> 4, dc = ch & 15, t = t0 - 128 + key;
            u32x4 v = (u32x4){0, 0, 0, 0};
            if (t >= 0) v = *(const u32x4*)(P + (size_t)t * DIN + 1536 + dc * 8);
            *(LAS u32x4*)(KS + key * 136 + dc * 8) = v;
        }
        for (int ch = tid; ch < 192 * 16; ch += 512) {
            const int dc = ch / 192, key = ch % 192, t = t0 - 128 + key;
            u32x4 v = (u32x4){0, 0, 0, 0};
            if (t >= 0) v = *(const u32x4*)(P + (size_t)t * DIN + 1664 + dc * 8);
            LAS bf16* vp = VT + (dc * 8) * 200 + key;
            vp[0] = (bf16)(v.x & 0xffffu); vp[200] = (bf16)(v.x >> 16); vp[400] = (bf16)(v.y & 0xffffu); vp[600] = (bf16)(v.y >> 16);
            vp[800] = (bf16)(v.z & 0xffffu); vp[1000] = (bf16)(v.z >> 16); vp[1200] = (bf16)(v.w & 0xffffu); vp[1400] = (bf16)(v.w >> 16);
        }
        bf16x8 qf[4][2];
#pragma unroll
        for (int qb = 0; qb < 4; ++qb)
#pragma unroll
            for (int kk = 0; kk < 2; ++kk) qf[qb][kk] = *(const bf16x8*)(P + (size_t)(t0 + 16 * qb + fr) * DIN + 1024 + h * 64 + 32 * kk + 8 * fq);
        if (t0 >= SEQ - 128) {
            float* pk = C.out + O_PK + (size_t)((l * 2 + b) * 128) * 128; float* pv = C.out + O_PV + (size_t)((l * 2 + b) * 128) * 128;
            for (int idx = tid; idx < 64 * 128; idx += 512) {
                const int row = idx >> 7, col = idx & 127, t = t0 + row;
                pk[(size_t)(t - (SEQ - 128)) * 128 + col] = bf2f(P[(size_t)t * DIN + 1536 + col]);
                pv[(size_t)(t - (SEQ - 128)) * 128 + col] = bf2f(P[(size_t)t * DIN + 1664 + col]);
            }
        }
        __syncthreads();
        const float sink = C.ap->in[IN_SINKS][l * 8 + h];
        const int kmin = 128 - t0;
        f32x4 o[4][4];
#pragma unroll
        for (int qb = 0; qb < 4; ++qb) {
            f32x4 s[12];
#pragma unroll
            for (int kb = 0; kb < 12; ++kb) {
                s[kb] = (f32x4){0.f, 0.f, 0.f, 0.f};
#pragma unroll
                for (int kk = 0; kk < 2; ++kk) {
                    const bf16x8 kf = *(const LAS bf16x8*)(KS + (16 * kb + fr) * 136 + kvh * 64 + 32 * kk + 8 * fq);
                    s[kb] = __builtin_amdgcn_mfma_f32_16x16x32_bf16(kf, qf[qb][kk], s[kb], 0, 0, 0);
                }
            }
            const int qrel = 16 * qb + fr;
            float mx = -1e30f;
#pragma unroll
            for (int kb = 0; kb < 12; ++kb)
#pragma unroll
                for (int j = 0; j < 4; ++j) {
                    const int kidx = 16 * kb + 4 * fq + j;
                    const bool valid = (kidx > qrel) && (kidx <= qrel + 128) && (kidx >= kmin);
                    const float v = valid ? s[kb][j] * 0.125f : -1e30f;
                    s[kb][j] = v; mx = fmaxf(mx, v);
                }
            mx = fmaxf(mx, __shfl_xor(mx, 16)); mx = fmaxf(mx, __shfl_xor(mx, 32)); mx = fmaxf(mx, sink);
            float sum = 0.f;
#pragma unroll
            for (int kb = 0; kb < 12; ++kb)
#pragma unroll
                for (int j = 0; j < 4; ++j) { const float p = __expf(s[kb][j] - mx); s[kb][j] = p; sum += p; }
            sum += __shfl_xor(sum, 16); sum += __shfl_xor(sum, 32);
            const float inv = 1.0f / (sum + __expf(sink - mx));
            bf16x8 pf[6];
#pragma unroll
            for (int c6 = 0; c6 < 6; ++c6) {
                u32x4 w; w.x = pk2(s[2 * c6][0], s[2 * c6][1]); w.y = pk2(s[2 * c6][2], s[2 * c6][3]); w.z = pk2(s[2 * c6 + 1][0], s[2 * c6 + 1][1]); w.w = pk2(s[2 * c6 + 1][2], s[2 * c6 + 1][3]);
                pf[c6] = __builtin_bit_cast(bf16x8, w);
            }
            float ss = 0.f;
#pragma unroll
            for (int db = 0; db < 4; ++db) {
                f32x4 a = (f32x4){0.f, 0.f, 0.f, 0.f};
#pragma unroll
                for (int c6 = 0; c6 < 6; ++c6) {
                    const LAS bf16* vp = VT + (kvh * 64 + 16 * db + fr) * 200 + 32 * c6 + 4 * fq;
                    const u32x2 lo = *(const LAS u32x2*)vp, hi = *(const LAS u32x2*)(vp + 16);
                    u32x4 w; w.x = lo.x; w.y = lo.y; w.z = hi.x; w.w = hi.y;
                    a = __builtin_amdgcn_mfma_f32_16x16x32_bf16(__builtin_bit_cast(bf16x8, w), pf[c6], a, 0, 0, 0);
                }
                a = a * inv; o[qb][db] = a;
                ss += (a.x * a.x + a.y * a.y) + (a.z * a.z + a.w * a.w);
            }
            ss += __shfl_xor(ss, 16); ss += __shfl_xor(ss, 32);
            if (fq == 0) SSQ[h * 64 + 16 * qb + fr] = ss;
        }
        __syncthreads();
        const float* ga = mixg + 512 + h * 64 + 4 * fq;
#pragma unroll
        for (int qb = 0; qb < 4; ++qb) {
            float tot = 0.f;
#pragma unroll
            for (int hh = 0; hh < 8; ++hh) tot += SSQ[hh * 64 + 16 * qb + fr];
            const float sc = 1.0f / sqrtf(tot * (1.f / 512.f) + RMS_EPS);
            bf16* yr = Y + (size_t)(16 * qb + fr) * D + 512 + h * 64 + 4 * fq;
#pragma unroll
            for (int db = 0; db < 4; ++db) {
                const f32x4 gg = *(const f32x4*)(ga + 16 * db), a = o[qb][db];
                u32x2 w; w.x = pk2(a.x * sc * gg.x, a.y * sc * gg.y); w.y = pk2(a.z * sc * gg.z, a.w * sc * gg.w);
                *(u32x2*)(yr + 16 * db) = w;
            }
        }
    }
}

__device__ __forceinline__ void mixer_sample(const Ctx& C, int l, int s) {
    const int tid = C.tid, wave = C.wave, lane = C.lane;
    const bf16* PR = (const bf16*)(C.ws + WS_PROJ) + (size_t)(MP + s) * DIN;
    bf16* Y = (bf16*)(C.ws + WS_YMIX) + (size_t)(MP + s) * D;
    LAS unsigned char* lds = C.lds;
    LAS float* KL = (LAS float*)lds;
    LAS float* VL = (LAS float*)(lds + 66048);
    LAS float* YS = (LAS float*)(lds + 132096);
    LAS float* PLS = (LAS float*)(lds + 136192);
    LAS float* QL = (LAS float*)(lds + 137216);
    LAS float* PB = (LAS float*)(lds + 139264);
    LAS float* WS2 = (LAS float*)(lds + 143360);
    const float* mixg = C.ap->in[IN_MIXG] + (size_t)l * D;
    __syncthreads();
    if (tid < 256) {
        const int c = tid;
        const float gb = bf2f(PR[c]), cv = bf2f(PR[256 + c]) * bf2f(PR[512 + c]);
        const float* sc = C.ap->in[IN_SCONV] + (size_t)((l * MS + s) * 2) * 256;
        const float s0 = sc[c], s1 = sc[256 + c];
        const float* cw = C.ap->in[IN_CONVW] + (size_t)l * 768;
        YS[c] = gb * (cw[c] * s0 + cw[256 + c] * s1 + cw[512 + c] * cv);
        float* oc = C.out + O_SC + (size_t)((l * MS + s) * 2) * 256;
        oc[c] = s1; oc[256 + c] = cv;
    } else {
        const int c = tid - 256, g = c >> 6, w = 2 << g;
        const float uu = bf2f(PR[768 + c]);
        const float* sp = C.ap->in[IN_SPOOL] + (size_t)((l * MS + s) * 15) * 256;
        float* op = C.out + O_SP + (size_t)((l * MS + s) * 15) * 256;
        float sum = uu;
#pragma unroll
        for (int j = 0; j < 15; ++j) {
            const float v = sp[(14 - j) * 256 + c];
            if (j < w - 1) sum += v;
            if (j < 14) op[(13 - j) * 256 + c] = v;
        }
        op[14 * 256 + c] = uu;
        PLS[c] = sum / (float)w - uu;
    }
    QL[tid] = bf2f(PR[1024 + tid]);
    {
        const float* ck = C.ap->in[IN_CK] + (size_t)(l * MS + s) * 16384; const float* cvp = C.ap->in[IN_CV] + (size_t)(l * MS + s) * 16384;
        float* ok = C.out + O_SK + (size_t)(l * MS + s) * 16384; float* ov = C.out + O_SV + (size_t)(l * MS + s) * 16384;
        for (int ch = tid; ch < 128 * 32; ch += 512) {
            const int key = ch >> 5, c4 = (ch & 31) * 4;
            f32x4 kv, vv;
            if (key < 127) { kv = *(const f32x4*)(ck + (size_t)(key + 1) * 128 + c4); vv = *(const f32x4*)(cvp + (size_t)(key + 1) * 128 + c4); }
            else { kv = (f32x4){bf2f(PR[1536 + c4]), bf2f(PR[1536 + c4 + 1]), bf2f(PR[1536 + c4 + 2]), bf2f(PR[1536 + c4 + 3])};
                   vv = (f32x4){bf2f(PR[1664 + c4]), bf2f(PR[1664 + c4 + 1]), bf2f(PR[1664 + c4 + 2]), bf2f(PR[1664 + c4 + 3])}; }
            *(f32x4*)(ok + (size_t)key * 128 + c4) = kv; *(f32x4*)(ov + (size_t)key * 128 + c4) = vv;
            LAS float* kd = KL + key * 129 + c4; LAS float* vd = VL + key * 129 + c4;
            kd[0] = kv.x; kd[1] = kv.y; kd[2] = kv.z; kd[3] = kv.w; vd[0] = vv.x; vd[1] = vv.y; vd[2] = vv.z; vd[3] = vv.w;
        }
    }
    __syncthreads();
    if (tid < 256) {
        const int g = tid >> 6, dd = tid & 63;
        const float* pw = C.ap->in[IN_POOLW] + (size_t)((l * 4 + g) * 64) * 64 + dd;
        float acc = 0.f;
#pragma unroll 8
        for (int c = 0; c < 64; ++c) acc += PLS[g * 64 + c] * pw[c * 64];
        YS[256 + tid] = acc * C.ap->in[IN_PSCALE][l * 256 + tid];
    }
    {
        const int h = wave, kvh = h >> 2;
        const float sink = C.ap->in[IN_SINKS][l * 8 + h];
        float s0 = 0.f, s1 = 0.f;
#pragma unroll 8
        for (int d = 0; d < 64; ++d) { const float q = QL[h * 64 + d]; s0 += q * KL[lane * 129 + kvh * 64 + d]; s1 += q * KL[(lane + 64) * 129 + kvh * 64 + d]; }
        s0 *= 0.125f; s1 *= 0.125f;
        const float mx = fmaxf(wave_max(fmaxf(s0, s1)), sink);
        const float p0 = __expf(s0 - mx), p1 = __expf(s1 - mx);
        const float inv = 1.0f / (wave_sum(p0 + p1) + __expf(sink - mx));
        PB[h * 128 + lane] = p0; PB[h * 128 + 64 + lane] = p1;
        asm volatile("s_waitcnt lgkmcnt(0)" ::: "memory");
        float acc = 0.f;
#pragma unroll 8
        for (int j = 0; j < 128; ++j) acc += PB[h * 128 + j] * VL[j * 129 + kvh * 64 + lane];
        YS[512 + h * 64 + lane] = acc * inv;
    }
    __syncthreads();
    {
        const float v0 = YS[tid], v1 = YS[tid + 512];
        const float a = wave_sum(v0 * v0), bsum = wave_sum(v1 * v1);
        if (lane == 0) { WS2[wave * 2] = a; WS2[wave * 2 + 1] = bsum; }
        __syncthreads();
        float seg = 0.f, seg2 = 0.f;
        const int wlo = tid < 256 ? 0 : 4;
#pragma unroll
        for (int w = 0; w < 4; ++w) seg += WS2[(wlo + w) * 2];
#pragma unroll
        for (int w = 0; w < 8; ++w) seg2 += WS2[w * 2 + 1];
        Y[tid] = (bf16)f2bf(v0 / sqrtf(seg * (1.f / 256.f) + RMS_EPS) * mixg[tid]);
        Y[tid + 512] = (bf16)f2bf(v1 / sqrtf(seg2 * (1.f / 512.f) + RMS_EPS) * mixg[tid + 512]);
    }
}

#define RLX_AGENT __ATOMIC_RELAXED, __HIP_MEMORY_SCOPE_AGENT
#define XB_TMO      128
#define XB_XCNT(j)  (256  + 64 * (j))
#define XB_XSUB(j)  (1280 + 64 * (j))
#define XB_XGEN(j)  (2304 + 64 * (j))
#define XB_TOP      3328
#define XB_TOPGEN   3392
#define XCD_BAR_WORDS 3456
#define XB_SPIN_CAP (1u << 18)

__device__ __forceinline__ unsigned xb_ld(unsigned* p)              { return __hip_atomic_load(p, __ATOMIC_RELAXED, __HIP_MEMORY_SCOPE_AGENT); }
__device__ __forceinline__ unsigned xb_add(unsigned* p, unsigned v) { return __hip_atomic_fetch_add(p, v, __ATOMIC_RELAXED, __HIP_MEMORY_SCOPE_AGENT); }
__device__ __forceinline__ unsigned xb_xcc_id() { return (unsigned)__builtin_amdgcn_s_getreg((3 << 11) | 20) & 0xFu; }
#define XB_SPIN(cond, bar) do { unsigned _sp = 0; while (cond) { __builtin_amdgcn_s_sleep(1); \
    if ((++_sp & 255u) == 0u) { if (xb_ld(&(bar)[XB_TMO])) break; if (_sp > XB_SPIN_CAP) { atomicAdd(&(bar)[XB_TMO], 1u); break; } } } } while (0)

struct XcdBarrier {
    unsigned* bar; unsigned x;
    volatile LAS unsigned* st;
};

__device__ __forceinline__ XcdBarrier xcd_barrier_post(unsigned* bar, volatile LAS unsigned* st) {
    XcdBarrier b; b.bar = bar; b.x = xb_xcc_id(); b.st = st;
    if (threadIdx.x == 0) (void)xb_add(&bar[XB_XCNT(b.x)], 1u);
    return b;
}
__device__ __forceinline__ void xcd_barrier_complete(unsigned* bar, unsigned x, unsigned& nloc, unsigned& nx) {
    const unsigned G = gridDim.x * gridDim.y * gridDim.z;
    unsigned sum, cnt, mine, sp = 0u;
    for (;;) {
        sum = 0u; cnt = 0u; mine = 0u;
#pragma unroll
        for (unsigned j = 0; j < 16; ++j) { const unsigned c = xb_ld(&bar[XB_XCNT(j)]); sum += c; cnt += (c > 0u) ? 1u : 0u; mine = (j == x) ? c : mine; }
        if (sum == G) break;
        __builtin_amdgcn_s_sleep(1);
        if ((++sp & 255u) == 0u) { if (xb_ld(&bar[XB_TMO])) break; if (sp > XB_SPIN_CAP) { atomicAdd(&bar[XB_TMO], 1u); break; } }
    }
    nloc = mine > 0u ? mine : 1u; nx = cnt > 0u ? cnt : 1u;
}

__device__ __forceinline__ void xcd_barrier(const XcdBarrier& b) {
    asm volatile("s_waitcnt vmcnt(0)" ::: "memory");
    __syncthreads();
    if (threadIdx.x == 0) {
        unsigned* bar = b.bar;
        __builtin_amdgcn_s_waitcnt(0);
        unsigned nloc = b.st[0], nx = b.st[1];
        if (nloc == 0u) { xcd_barrier_complete(bar, b.x, nloc, nx); b.st[0] = nloc; b.st[1] = nx; }
        const unsigned old = xb_add(&bar[XB_XSUB(b.x)], 1u);
        const unsigned gen = old / nloc;
        if (old + 1u == (gen + 1u) * nloc) {
            __builtin_amdgcn_fence(__ATOMIC_RELEASE, "agent");
            asm volatile("s_waitcnt vmcnt(0)" ::: "memory");
            const unsigned og = xb_add(&bar[XB_TOP], 1u);
            const unsigned tg = og / nx;
            if (og + 1u == (tg + 1u) * nx) xb_add(&bar[XB_TOPGEN], 1u);
            else XB_SPIN(xb_ld(&bar[XB_TOPGEN]) == tg, bar);
            __builtin_amdgcn_fence(__ATOMIC_ACQUIRE, "agent");
            xb_add(&bar[XB_XGEN(b.x)], 1u);
            asm volatile("s_waitcnt vmcnt(0)" ::: "memory");
        } else {
            XB_SPIN(xb_ld(&bar[XB_XGEN(b.x)]) == gen, bar);
            __builtin_amdgcn_fence(__ATOMIC_ACQUIRE, "agent");
            asm volatile("s_waitcnt vmcnt(0)" ::: "memory");
        }
    }
    __syncthreads();
}

#ifndef PROBE_K
#define PROBE_K -1
#endif
constexpr int PER_L = 10 + ((PROBE_K >= 0 && PROBE_K < 10) ? 1 : 0);
constexpr int NPRE = 3 + (PROBE_K == 100 ? 1 : 0);
constexpr int NSTEP = NPRE + PER_L * DEPTH;
__device__ __forceinline__ int step_phase(int st) {
    if (st < NPRE) return PROBE_K == 100 ? (st == 0 ? 0 : st - 1) : st;
    const int q = st - NPRE, l = q / PER_L, pos = q % PER_L;
    const int k = (PROBE_K >= 0 && PROBE_K < 10 && pos > PROBE_K) ? pos - 1 : pos;
    return 3 + 10 * l + k;
}
__global__ void __launch_bounds__(NWAVES * 64, 2) fwd_kernel(Args args) {
    extern __shared__ __attribute__((aligned(16))) unsigned char lds_raw[];
    cg::grid_group grid = cg::this_grid();
    const int ph_lo = args.ph_lo, ph_hi = args.ph_hi;
    volatile LAS unsigned* bst = (volatile LAS unsigned*)((LAS unsigned char*)lds_raw + XB_ST_OFF);
    if (threadIdx.x < 4) bst[threadIdx.x] = 0u;
    __syncthreads();
    const XcdBarrier xbar = xcd_barrier_post((unsigned*)args.ws, bst);
    for (int st = ph_lo; st < ph_hi; ++st) {
        if (st > ph_lo) { if (st == ph_lo + 1) grid.sync(); else xcd_barrier(xbar); }
        const int ph = step_phase(st);
        kargs_t ap = (kargs_t)__builtin_amdgcn_kernarg_segment_ptr(); asm volatile("" : "+s"(ap));
        int tid = threadIdx.x; asm volatile("" : "+v"(tid));
        Ctx C; C.ap = ap; C.out = ap->out; C.ws = ap->ws; C.lds = (LAS unsigned char*)lds_raw;
        C.tid = tid; C.lane = tid & 63; C.wave = __builtin_amdgcn_readfirstlane(tid >> 6); C.G = gridDim.x; C.bid = blockIdx.x;
        unsigned char* ws = C.ws;
        float* XB = (float*)(ws + WS_XB); float* YB = (float*)(ws + WS_YB); bf16* HB = (bf16*)(ws + WS_HB); bf16* HID = (bf16*)(ws + WS_HID);
        bf16* PROJ = (bf16*)(ws + WS_PROJ); bf16* YMIX = (bf16*)(ws + WS_YMIX); float* MOD = (float*)(ws + WS_MOD);
        if (ph == 0) { p0_prologue(C); continue; }
        if (ph == 1) {
            pg8::Gemm g{(const bf16*)(ws + WS_AC), (const bf16*)(ws + WS_HID), 256, NMODC, D}; pg8::StaticOrder S; S.init(256, NMODC, C.G, C.bid);
            pg8::EpiMod E{MOD, C.ap->in[IN_BADA]};
            pg8::gemm_phase<pg8::EpiMod, pg8::StaticOrder, true, true>(C.lds, g, S, E); continue;
        }
        if (ph == 2) { ln_phase(C, XB, false, nullptr, nullptr, nullptr, HB, MOD + 0 * D, MOD + 1 * D); continue; }
        const int l = (ph - 3) / 10, k = (ph - 3) % 10;
        unsigned char* wl = ws + WS_W + (size_t)l * WL_BYTES;
        const float* modl = MOD + (size_t)l * 9 * D;
        if (k == 0 || k == 7) {
            pg8::Gemm g{HB, (const bf16*)(wl + (k == 0 ? WO_GU1 : WO_GU2)), MT, NGU, D}; pg8::StaticOrder S; S.init(MT, NGU, C.G, C.bid);
            pg8::EpiSwiGLU E{HID};
            pg8::gemm_phase<pg8::EpiSwiGLU, pg8::StaticOrder, true, true>(C.lds, g, S, E);
        } else if (k == 1 || k == 8) {
            pg8::Gemm g{HID, (const bf16*)(wl + (k == 1 ? WO_D1 : WO_D2)), MT, D, DFF}; pg8::StaticOrder S; S.init(MT, D, C.G, C.bid);
            pg8::EpiResid E{XB, YB, modl + (k == 1 ? 2 : 8) * D, 0.5f};
            pg8::gemm_phase<pg8::EpiResid, pg8::StaticOrder, true, true>(C.lds, g, S, E);
        } else if (k == 5) {
            pg8::Gemm g{YMIX, (const bf16*)(wl + WO_OUT), MT, D, D}; pg8::StaticOrder S; S.init(MT, D, C.G, C.bid);
            pg8::EpiResid E{XB, YB, modl + 5 * D, 1.0f};
            pg8::gemm_phase<pg8::EpiResid, pg8::StaticOrder, true, true>(C.lds, g, S, E);
        } else if (k == 3) {
            pg8::Gemm g{HB, (const bf16*)(wl + WO_IN), MT, DIN, D}; pg8::StaticOrder S; S.init(MT, DIN, C.G, C.bid);
            pg8::EpiBf16<0> E{PROJ, DIN, nullptr, 0, 0, 1.f};
            pg8::gemm_phase<pg8::EpiBf16<0>, pg8::StaticOrder, true, true>(C.lds, g, S, E);
        } else if (k == 4) {
            for (int u = C.bid; u < 256 + MS; u += C.G) { if (u < 256) mixer_prompt_tile(C, l, u); else mixer_sample(C, l, u - 256); }
        } else {
            const int li = k == 2 ? 0 : (k == 6 ? 1 : 2);
            const float* lg = C.ap->in[IN_LNG] + (size_t)(l * 3 + li) * D; const float* lb = C.ap->in[IN_LNB] + (size_t)(l * 3 + li) * D;
            if (k == 2) ln_phase(C, YB, true, lg, lb, XB, HB, modl + 3 * D, modl + 4 * D);
            else if (k == 6) ln_phase(C, YB, true, lg, lb, XB, HB, modl + 6 * D, modl + 7 * D);
            else if (l < DEPTH - 1) ln_phase(C, YB, true, lg, lb, XB, HB, modl + 9 * D, modl + 10 * D);
            else ln_phase(C, YB, true, lg, lb, C.out, nullptr, nullptr, nullptr);
        }
    }
}

extern "C" void kernel_launch(void* const* d_in, const int* in_sizes, int n_in, void* d_out, int out_size, void* d_ws, size_t ws_size, hipStream_t stream) {
    static int grid = 0;
    if (grid == 0) {
        if (n_in != 25 || ws_size < WS_END) { fprintf(stderr, "kernel_launch: need 25 inputs and %zu bytes of workspace; got %d, %zu\n", (size_t)WS_END, n_in, ws_size); grid = -1; return; }
        int dev = 0, cus = 0, per_cu = 0;
        if (hipGetDevice(&dev) != hipSuccess || hipDeviceGetAttribute(&cus, hipDeviceAttributeMultiprocessorCount, dev) != hipSuccess) { grid = -1; return; }
        if (hipFuncSetAttribute((const void*)fwd_kernel, hipFuncAttributeMaxDynamicSharedMemorySize, LDS_BYTES) != hipSuccess) { fprintf(stderr, "kernel_launch: hipFuncSetAttribute failed\n"); grid = -1; return; }
        if (hipOccupancyMaxActiveBlocksPerMultiprocessor(&per_cu, (const void*)fwd_kernel, NWAVES * 64, LDS_BYTES) != hipSuccess || per_cu < 1) { fprintf(stderr, "kernel_launch: occupancy query gave %d\n", per_cu); per_cu = 1; }
        (void)hipGetLastError();
        grid = cus * per_cu;
    }
    if (grid < 0) return;
    if (hipMemsetAsync(d_ws, 0, 16384, stream) != hipSuccess) { fprintf(stderr, "kernel_launch: memset failed\n"); return; }
    Args a{};
    for (int i = 0; i < 25; ++i) a.in[i] = (const float*)d_in[i];
    a.out = (float*)d_out; a.ws = (unsigned char*)d_ws;
#if MK_ONE_LAUNCH
    a.ph_lo = 0; a.ph_hi = NSTEP;
    void* kargs[] = {&a};
    hipError_t e = hipLaunchCooperativeKernel((const void*)fwd_kernel, dim3(grid), dim3(NWAVES * 64), kargs, LDS_BYTES, stream);
    if (e != hipSuccess) fprintf(stderr, "kernel_launch: cooperative launch failed: %s (grid %d)\n", hipGetErrorString(e), grid);
#else
    for (int ph = 0; ph < NSTEP; ++ph) {
        a.ph_lo = ph; a.ph_hi = ph + 1;
        hipLaunchKernelGGL(fwd_kernel, dim3(grid), dim3(NWAVES * 64), LDS_BYTES, stream, a);
    }
#endif
}
```

```cpp
#include <hip/hip_runtime.h>
#include <hip/hip_cooperative_groups.h>
#include <cstdio>
#include <cstdint>
namespace cg = cooperative_groups;
namespace pg8 {
#define PG8_LAS __attribute__((address_space(3)))
typedef unsigned short bf16_t;
typedef short bf16x8 __attribute__((ext_vector_type(8)));
typedef float f32x4 __attribute__((ext_vector_type(4)));
typedef unsigned u32x4 __attribute__((ext_vector_type(4)));
constexpr int BM = 256, BK = 64, HALF = 128, HTB = HALF * BK * 2  , STAGE_BYTES = 8 * HTB, NXCD = 8, WGM = 8;

__host__ __device__ __forceinline__ int lds_byte(int r, int c) { const int st = (r >> 4) * 2 + (c >> 5), rr = r & 15, cc = c & 31, ob = rr * 64 + cc * 2; return st * 1024 + (ob ^ (((ob >> 9) & 1) << 5)); }
__host__ __device__ __forceinline__ void stage_rc(int b, int& R, int& C) { const int st = b / 1024, sb = b % 1024, swz = sb ^ (((sb >> 9) & 1) << 5); R = (st >> 1) * 16 + swz / 64; C = (st & 1) * 32 + (swz % 64) / 2; }
__host__ __device__ __forceinline__ int perm32(int rho) { const int n = rho >> 4, i = rho & 15; return 8 * (i >> 2) + 4 * n + (i & 3); }

struct Unit { int pm, pn, k0, nk; };
struct Gemm { const bf16_t* A; const bf16_t* Bt; int M, N, K; };

struct StaticOrder {
    int nM, nN, nwg, G, c;
    __host__ __device__ void init(int M, int N, int G_, int c_) { nM = M / BM; nN = N / BM; nwg = nM * nN; G = G_; c = c_; }
    __host__ __device__ bool next(int i, Unit& u) const {
        const long L = (long)i * G + c; if (L >= nwg) return false;
        int wgid = (int)L; { const int q = nwg / NXCD, r = nwg % NXCD, xcd = wgid % NXCD, off = wgid / NXCD; wgid = (xcd < r ? xcd * (q + 1) : r * (q + 1) + (xcd - r) * q) + off; }
        const int nig = WGM * nN, gid = wgid / nig, fm = gid * WGM, gsz = (nM - fm) < WGM ? (nM - fm) : WGM;
        u.pm = fm + ((wgid % nig) % gsz); u.pn = (wgid % nig) / gsz; u.k0 = 0; u.nk = 0; return true;
    }
    __device__ __forceinline__ void a_ready(const Unit&) const {}
    __device__ __forceinline__ void done(const Unit&) const {}
};

__device__ __forceinline__ unsigned cvt_pk_bf16(float lo, float hi) { unsigned r; asm volatile("v_cvt_pk_bf16_f32 %0, %1, %2" : "=v"(r) : "v"(lo), "v"(hi)); return r; }
typedef float f32x2 __attribute__((ext_vector_type(2)));
__device__ __forceinline__ f32x2 gelu_pk(f32x2 v) {
    const f32x2 av = __builtin_elementwise_abs(v), d = av * 0.2316418882f + 1.0f;
    f32x2 t; t.x = __builtin_amdgcn_rcpf(d.x); t.y = __builtin_amdgcn_rcpf(d.y);
    f32x2 q = t * 0.5307027145f + (-0.7265760135f); q = q * t + 0.7107068705f; q = q * t + (-0.142248368f); q = q * t + 0.127414796f; q = q * t;
    const f32x2 s = (v * v) * (-0.72134752044f);
    f32x2 e; e.x = __builtin_amdgcn_exp2f(s.x); e.y = __builtin_amdgcn_exp2f(s.y);
    const f32x2 m = v * (q * e), r = v - m;
    f32x2 o; o.x = v.x < 0.f ? m.x : r.x; o.y = v.y < 0.f ? m.y : r.y; return o;
}

template <int ACT  > struct EpiBf16 {
    static constexpr bool PERM = true, AFTER_DRAIN = false; static_assert(ACT == 0 || ACT == 1, "EpiBf16: ACT is 0 (none) or 1 (gelu_pk)");
    bf16_t* O; int ldc; const float* bias; int split_cols; size_t split_stride; float scale0;
    __device__ __forceinline__ void operator()(const f32x4 (&acc)[2][2][4][2], const Unit& u, int wr, int wc, int fr, int fq) const {
        const int row0 = u.pm * BM + wr * 64 + fr; int colt = u.pn * BM; bf16_t* base = O;
        float sc = 1.f; if (split_cols) { const int t = colt / split_cols; base += (size_t)t * split_stride; colt -= t * split_cols; if (t == 0) sc = scale0; }
        const int col0 = colt + wc * 32 + 8 * fq, bcol0 = u.pn * BM + wc * 32 + 8 * fq;
        f32x4 bv[2][2];
#pragma unroll
        for (int bj = 0; bj < 2; ++bj)
#pragma unroll
            for (int n = 0; n < 2; ++n) bv[bj][n] = bias ? *(const f32x4*)(bias + bcol0 + bj * HALF + 4 * n) : (f32x4){0.f, 0.f, 0.f, 0.f};
#pragma unroll
        for (int ai = 0; ai < 2; ++ai)
#pragma unroll
            for (int m = 0; m < 4; ++m) { bf16_t* rowp = base + (size_t)(row0 + ai * HALF + m * 16) * ldc + col0;
#pragma unroll
                for (int bj = 0; bj < 2; ++bj) { f32x4 v0 = acc[ai][bj][m][0] + bv[bj][0], v1 = acc[ai][bj][m][1] + bv[bj][1];
                    if (ACT == 1) { f32x2 a = gelu_pk((f32x2){v0[0], v0[1]}), b = gelu_pk((f32x2){v0[2], v0[3]}), c = gelu_pk((f32x2){v1[0], v1[1]}), d = gelu_pk((f32x2){v1[2], v1[3]});
                        v0 = (f32x4){a.x, a.y, b.x, b.y}; v1 = (f32x4){c.x, c.y, d.x, d.y}; }
                    v0 = v0 * sc; v1 = v1 * sc; u32x4 w; w.x = cvt_pk_bf16(v0[0], v0[1]); w.y = cvt_pk_bf16(v0[2], v0[3]); w.z = cvt_pk_bf16(v1[0], v1[1]); w.w = cvt_pk_bf16(v1[2], v1[3]);
                    *(u32x4*)(rowp + bj * HALF) = w; } }
    }
};

struct PanelStats {
    unsigned* xbuf;
    unsigned* cnt;
    unsigned* tmo;
    int ntn; float eps;
    unsigned code;
    __device__ __forceinline__ bool run(const f32x4 (&v)[2][2][4][2], const Unit& u, int wr, int wc, int fr, int fq, PG8_LAS unsigned char* lds, int wid, int lane) const {
        typedef float f32x2v __attribute__((ext_vector_type(2)));
        PG8_LAS f32x2v* P = (PG8_LAS f32x2v*)lds;
        PG8_LAS f32x2v* S = (PG8_LAS f32x2v*)(lds + 8192);
        PG8_LAS unsigned* flag = (PG8_LAS unsigned*)(lds + 8192 + 2048);
#pragma unroll
        for (int ai = 0; ai < 2; ++ai)
#pragma unroll
            for (int m = 0; m < 4; ++m) {
                float s = 0.f;
#pragma unroll
                for (int bj = 0; bj < 2; ++bj)
#pragma unroll
                    for (int n = 0; n < 2; ++n) { const f32x4 x = v[ai][bj][m][n]; s += (x[0] + x[1]) + (x[2] + x[3]); }
                s += __shfl_xor(s, 16); s += __shfl_xor(s, 32);
                const float mw = s * (1.0f / 64.0f); float q = 0.f;
#pragma unroll
                for (int bj = 0; bj < 2; ++bj)
#pragma unroll
                    for (int n = 0; n < 2; ++n) { const f32x4 d = v[ai][bj][m][n] - mw; q += (d[0] * d[0] + d[1] * d[1]) + (d[2] * d[2] + d[3] * d[3]); }
                q += __shfl_xor(q, 16); q += __shfl_xor(q, 32);
                if (fq == 0) P[(ai * HALF + wr * 64 + m * 16 + fr) * 4 + wc] = (f32x2v){mw, q};
            }
        asm volatile("s_waitcnt lgkmcnt(0)" ::: "memory"); __builtin_amdgcn_s_barrier(); asm volatile("" ::: "memory");
#if defined(BROKEN_EXCHANGE_NO_WAIT)
#warning BROKEN CONTROL BUILD: the row-statistics exchange does not wait; results are wrong by design
        if (blockIdx.x >= 64) { const long long t0_ = clock64(); while (clock64() - t0_ < 60000) __builtin_amdgcn_s_sleep(8); }
#endif
        const int row = wid * 32 + (lane & 31);
        if (lane < 32) {
            const f32x2v a = P[row * 4 + 0], b = P[row * 4 + 1], c = P[row * 4 + 2], d = P[row * 4 + 3];
            const float mt = (a.x + b.x + c.x + d.x) * 0.25f;
            const float da = a.x - mt, db = b.x - mt, dc = c.x - mt, dd = d.x - mt;
            const float m2 = (a.y + b.y) + (c.y + d.y) + 64.0f * ((da * da + db * db) + (dc * dc + dd * dd));
            unsigned long long* slot = (unsigned long long*)xbuf + ((size_t)(u.pm * BM + row) * 4 + u.pn);
            __hip_atomic_store(slot, ((unsigned long long)__float_as_uint(m2) << 32) | __float_as_uint(mt), __ATOMIC_RELAXED, __HIP_MEMORY_SCOPE_AGENT);
        }
        asm volatile("s_waitcnt vmcnt(0)" ::: "memory");
        if (lane == 0) __hip_atomic_fetch_add(cnt + 64 * u.pm, 1u, __ATOMIC_RELAXED, __HIP_MEMORY_SCOPE_AGENT);
        if (wid == 0) {
            bool dead = false; const unsigned long long t0 = __builtin_amdgcn_s_memrealtime(); const unsigned want = 8u * (unsigned)ntn;
            for (;;) {
#if defined(BROKEN_EXCHANGE_NO_WAIT)
                break;
#endif
                if ((unsigned)__builtin_amdgcn_readfirstlane(__hip_atomic_load(cnt + 64 * u.pm, __ATOMIC_RELAXED, __HIP_MEMORY_SCOPE_AGENT)) >= want) break;
                if (__builtin_amdgcn_s_memrealtime() - t0 > 2000000ull) {
                    if (lane == 0) { unsigned expect = 0u; __hip_atomic_compare_exchange_strong(tmo + 1, &expect, code | (unsigned)(u.pm & 0xff), __ATOMIC_RELAXED, __ATOMIC_RELAXED, __HIP_MEMORY_SCOPE_AGENT);
                                     __hip_atomic_store(tmo, 1u, __ATOMIC_RELAXED, __HIP_MEMORY_SCOPE_AGENT); }
                    dead = true; break; }
                __builtin_amdgcn_s_sleep(2);
            }
            __builtin_amdgcn_fence(__ATOMIC_ACQUIRE, "agent");
            if (lane == 0) flag[0] = dead ? 1u : 0u;
        }
        asm volatile("s_waitcnt vmcnt(0) lgkmcnt(0)" ::: "memory"); __builtin_amdgcn_s_barrier(); asm volatile("" ::: "memory");
        const bool bad = flag[0] != 0u;
        if (lane < 32) {
            const unsigned long long* slot = (const unsigned long long*)xbuf + (size_t)(u.pm * BM + row) * 4; float mt[4], m2[4]; float ms = 0.f;
#pragma unroll
            for (int t = 0; t < 4; ++t) { if (t < ntn) { const unsigned long long w = __hip_atomic_load(slot + t, __ATOMIC_RELAXED, __HIP_MEMORY_SCOPE_AGENT); mt[t] = __uint_as_float((unsigned)w); m2[t] = __uint_as_float((unsigned)(w >> 32)); } else { mt[t] = 0.f; m2[t] = 0.f; } ms += mt[t]; }
            const float mean = ms / (float)ntn; float q = 0.f;
#pragma unroll
            for (int t = 0; t < 4; ++t) if (t < ntn) { const float dm = mt[t] - mean; q += m2[t] + 256.0f * dm * dm; }
            S[row] = (f32x2v){mean, 1.0f / sqrtf(q / (256.0f * (float)ntn) + eps)};
        }
        asm volatile("s_waitcnt lgkmcnt(0)" ::: "memory"); __builtin_amdgcn_s_barrier(); asm volatile("" ::: "memory");
        return bad;
    }
};
struct EpiLnRes {
    static constexpr bool PERM = false, AFTER_DRAIN = true;
    const float* base; float* out; int ldc; const float* bias; PanelStats st; unsigned poison;
    __device__ __forceinline__ void fused(f32x4 (&acc)[2][2][4][2], const Unit& u, int wr, int wc, int fr, int fq, PG8_LAS unsigned char* lds, int wid, int lane) const {
        typedef float f32x2v __attribute__((ext_vector_type(2)));
        const PG8_LAS f32x2v* S = (const PG8_LAS f32x2v*)(lds + 8192);
        const int col0 = u.pn * BM + wc * 32 + 4 * fq;
#pragma unroll
        for (int bj = 0; bj < 2; ++bj)
#pragma unroll
            for (int n = 0; n < 2; ++n) { const f32x4 bv = bias ? *(const f32x4*)(bias + col0 + bj * HALF + n * 16) : (f32x4){0.f, 0.f, 0.f, 0.f};
#pragma unroll
                for (int ai = 0; ai < 2; ++ai)
#pragma unroll
                    for (int m = 0; m < 4; ++m) acc[ai][bj][m][n] += bv; }
        f32x4 pre[4][2][2];
#pragma unroll
        for (int m = 0; m < 4; ++m) { const size_t off = (size_t)(u.pm * BM + wr * 64 + m * 16 + fr) * ldc + col0;
#pragma unroll
            for (int bj = 0; bj < 2; ++bj)
#pragma unroll
                for (int n = 0; n < 2; ++n) pre[m][bj][n] = *(const f32x4*)(base + off + bj * HALF + n * 16); }
        const bool bad = st.run(acc, u, wr, wc, fr, fq, lds, wid, lane) || poison != 0u;
        const float qnan = __builtin_nanf("");
#pragma unroll
        for (int ai = 0; ai < 2; ++ai)
#pragma unroll
            for (int m = 0; m < 4; ++m) { const int r = ai * HALF + wr * 64 + m * 16 + fr; const f32x2v sr = S[r]; const size_t off = (size_t)(u.pm * BM + r) * ldc + col0;
#pragma unroll
                for (int bj = 0; bj < 2; ++bj)
#pragma unroll
                    for (int n = 0; n < 2; ++n) { const f32x4 bs = ai == 0 ? pre[m][bj][n] : *(const f32x4*)(base + off + bj * HALF + n * 16); f32x4 o = bs + (acc[ai][bj][m][n] - sr.x) * sr.y;
                        if (bad) o = (f32x4){qnan, qnan, qnan, qnan}; *(f32x4*)(out + off + bj * HALF + n * 16) = o; }
                if (m & 1) asm volatile("" ::: "memory"); }
    }
};
struct EpiLnResLn {
    static constexpr bool PERM = false, AFTER_DRAIN = true;
    const float* base; float* out; bf16_t* xn; int ldc; const float* bias; PanelStats st1, st2; unsigned poison;
    __device__ __forceinline__ void fused(f32x4 (&acc)[2][2][4][2], const Unit& u, int wr, int wc, int fr, int fq, PG8_LAS unsigned char* lds, int wid, int lane) const {
        typedef float f32x2v __attribute__((ext_vector_type(2))); typedef unsigned u32x2v __attribute__((ext_vector_type(2)));
        const PG8_LAS f32x2v* S = (const PG8_LAS f32x2v*)(lds + 8192);
        const int col0 = u.pn * BM + wc * 32 + 4 * fq;
#pragma unroll
        for (int bj = 0; bj < 2; ++bj)
#pragma unroll
            for (int n = 0; n < 2; ++n) { const f32x4 bv = bias ? *(const f32x4*)(bias + col0 + bj * HALF + n * 16) : (f32x4){0.f, 0.f, 0.f, 0.f};
#pragma unroll
                for (int ai = 0; ai < 2; ++ai)
#pragma unroll
                    for (int m = 0; m < 4; ++m) acc[ai][bj][m][n] += bv; }
        bool bad = st1.run(acc, u, wr, wc, fr, fq, lds, wid, lane) || poison != 0u;
        const float qnan = __builtin_nanf("");
#pragma unroll
        for (int ai = 0; ai < 2; ++ai)
#pragma unroll
            for (int m = 0; m < 4; ++m) { const int r = ai * HALF + wr * 64 + m * 16 + fr; const f32x2v sr = S[r]; const size_t off = (size_t)(u.pm * BM + r) * ldc + col0;
#pragma unroll
                for (int bj = 0; bj < 2; ++bj)
#pragma unroll
                    for (int n = 0; n < 2; ++n) { const f32x4 bs = *(const f32x4*)(base + off + bj * HALF + n * 16); acc[ai][bj][m][n] = bs + (acc[ai][bj][m][n] - sr.x) * sr.y; }
                asm volatile("" : "+v"(acc[ai][0][m][0]), "+v"(acc[ai][0][m][1]), "+v"(acc[ai][1][m][0]), "+v"(acc[ai][1][m][1]));
                if (m & 1) asm volatile("" ::: "memory"); }
        const bool bad1 = bad;
        bad = st2.run(acc, u, wr, wc, fr, fq, lds, wid, lane) || bad;
#pragma unroll
        for (int ai = 0; ai < 2; ++ai)
#pragma unroll
            for (int m = 0; m < 4; ++m) { const int r = ai * HALF + wr * 64 + m * 16 + fr; const f32x2v sr = S[r]; const size_t off = (size_t)(u.pm * BM + r) * ldc + col0;
#pragma unroll
                for (int bj = 0; bj < 2; ++bj)
#pragma unroll
                    for (int n = 0; n < 2; ++n) { const f32x4 x1 = acc[ai][bj][m][n]; *(f32x4*)(out + off + bj * HALF + n * 16) = bad1 ? (f32x4){qnan, qnan, qnan, qnan} : x1;
                        const f32x4 o = (x1 - sr.x) * sr.y; u32x2v w; w.x = cvt_pk_bf16(o[0], o[1]); w.y = cvt_pk_bf16(o[2], o[3]);
                        if (bad) { w.x = 0x7fc07fc0u; w.y = 0x7fc07fc0u; } *(u32x2v*)(xn + off + bj * HALF + n * 16) = w; }
                asm volatile("" ::: "memory"); }
    }
};

template <class Epi, class Sched, bool ALIGN_EPI = false, bool SP2 = false>
__device__ __forceinline__ void gemm_phase(PG8_LAS unsigned char* lds, const Gemm g, const Sched& S, const Epi& E) {
    int tid = threadIdx.x; asm volatile("" : "+v"(tid));
    const int wid = __builtin_amdgcn_readfirstlane(tid >> 6), lane = tid & 63, wr = wid >> 2, wc = wid & 3, fr = lane & 15, fq = lane >> 4;
    const int K = g.K, nt = K / BK;
    unsigned voffA[2], voffB[2];
#pragma unroll
    for (int i = 0; i < 2; ++i) { int R, C; stage_rc(tid * 16 + i * 8192, R, C); const int Rb = Epi::PERM ? ((R & ~31) + perm32(R & 31)) : R;
        voffA[i] = (unsigned)(R * K + C) * 2u; voffB[i] = (unsigned)(Rb * K + C) * 2u; }
    const size_t kstep = (size_t)(BK * 2);
    const size_t hstep = (size_t)HALF * K * 2;
    const size_t tstep = 2 * hstep;
    const unsigned ldsw = (unsigned)wid * 1024u;
    const int aoff = lds_byte(wr * 64 + fr, fq * 8), boff = lds_byte(wc * 32 + fr, fq * 8);
#define PG8_SA(b, h) (((b) * 2 + (h)) * HTB)
#define PG8_SB(b, h) ((4 + (b) * 2 + (h)) * HTB)
#define PG8_STAGE(bufoff, gbase, voff) do { _Pragma("unroll") for (int _i = 0; _i < 2; ++_i) \
        __builtin_amdgcn_global_load_lds((const unsigned*)((const char*)(gbase) + (voff)[_i]), (PG8_LAS unsigned*)(lds + (bufoff) + ldsw + _i * 8192), 16, 0, 0); } while (0)
#define PG8_LDA(dst, b, h) do { _Pragma("unroll") for (int m = 0; m < 4; ++m) _Pragma("unroll") for (int k = 0; k < 2; ++k) dst[m][k] = *(const PG8_LAS bf16x8*)(lds + PG8_SA(b, h) + aoff + m * 2048 + k * 1024); } while (0)
#define PG8_LDB(dst, b, h) do { _Pragma("unroll") for (int n = 0; n < 2; ++n) _Pragma("unroll") for (int k = 0; k < 2; ++k) dst[n][k] = *(const PG8_LAS bf16x8*)(lds + PG8_SB(b, h) + boff + n * 2048 + k * 1024); } while (0)
#define PG8_MMA(ai, bj, At, Bt) do { __builtin_amdgcn_s_setprio(1); _Pragma("unroll") for (int m = 0; m < 4; ++m) _Pragma("unroll") for (int n = 0; n < 2; ++n) _Pragma("unroll") for (int k = 0; k < 2; ++k) \
        acc[ai][bj][m][n] = __builtin_amdgcn_mfma_f32_16x16x32_bf16(Bt[n][k], At[m][k], acc[ai][bj][m][n], 0, 0, 0); __builtin_amdgcn_s_setprio(0); } while (0)
#define PG8_WAIT_V(n) asm volatile("s_waitcnt vmcnt(" #n ")" ::: "memory")
#define PG8_WAIT_L(n) asm volatile("s_waitcnt lgkmcnt(" #n ")" ::: "memory")
#define PG8_BAR __builtin_amdgcn_s_barrier()
#define PG8_SCHED __builtin_amdgcn_sched_barrier(0)
    Unit cur, nxt; int ui = 0;
    if (!S.next(0, cur)) return;
    f32x4 acc[2][2][4][2];
#pragma unroll
    for (int a = 0; a < 2; ++a)
#pragma unroll
        for (int b = 0; b < 2; ++b)
#pragma unroll
            for (int m = 0; m < 4; ++m)
#pragma unroll
                for (int n = 0; n < 2; ++n) acc[a][b][m][n] = (f32x4){0.f, 0.f, 0.f, 0.f};
    bf16x8 At[4][2], B0[2][2], B1[2][2];
    const char* cA = (const char*)g.A + (size_t)cur.pm * tstep + (size_t)cur.k0 * kstep; const char* cB = (const char*)g.Bt + (size_t)cur.pn * tstep + (size_t)cur.k0 * kstep;
    S.a_ready(cur);
    if constexpr (SP2) {
        PG8_STAGE(PG8_SB(0, 0), cB, voffB); PG8_STAGE(PG8_SB(0, 1), cB + hstep, voffB); PG8_STAGE(PG8_SA(0, 0), cA, voffA); PG8_STAGE(PG8_SA(0, 1), cA + hstep, voffA);
        if (wr == 1) PG8_BAR;
        PG8_WAIT_V(2); PG8_BAR;
        PG8_STAGE(PG8_SB(1, 0), cB + kstep, voffB); PG8_STAGE(PG8_SA(1, 0), cA + kstep, voffA); PG8_STAGE(PG8_SB(1, 1), cB + hstep + kstep, voffB);
        PG8_WAIT_V(6); PG8_BAR;
    } else {
        PG8_STAGE(PG8_SB(0, 0), cB, voffB); PG8_STAGE(PG8_SA(0, 0), cA, voffA); PG8_STAGE(PG8_SB(0, 1), cB + hstep, voffB); PG8_STAGE(PG8_SA(0, 1), cA + hstep, voffA);
        if (wr == 1) PG8_BAR;
        PG8_WAIT_V(4); PG8_BAR;
        PG8_STAGE(PG8_SB(1, 0), cB + kstep, voffB); PG8_STAGE(PG8_SA(1, 0), cA + kstep, voffA); PG8_STAGE(PG8_SB(1, 1), cB + hstep + kstep, voffB);
        PG8_WAIT_V(6); PG8_BAR;
    }
    for (;;) {
        const bool has_next = S.next(ui + 1, nxt);
        const char* nA = has_next ? (const char*)g.A + (size_t)nxt.pm * tstep + (size_t)nxt.k0 * kstep : cA; const char* nB = has_next ? (const char*)g.Bt + (size_t)nxt.pn * tstep + (size_t)nxt.k0 * kstep : cB;
        const int cnk = cur.nk ? cur.nk : nt;
        for (int t = 0; t < cnk; t += 2) {
            const bool last = (t == cnk - 2);
            const char* a1 = cA + (size_t)(t + 1) * kstep;
            const char* a2 = last ? nA : cA + (size_t)(t + 2) * kstep; const char* b2 = last ? nB : cB + (size_t)(t + 2) * kstep;
            const char* a3 = a2 + kstep; const char* b3 = b2 + kstep;
            if (last && has_next) S.a_ready(nxt);
            if constexpr (SP2) {
            PG8_LDB(B0, 0, 0); PG8_LDB(B1, 0, 1); PG8_SCHED; PG8_LDA(At, 0, 0); PG8_STAGE(PG8_SA(1, 1), a1 + hstep, voffA);
            PG8_WAIT_V(8); PG8_WAIT_L(0); PG8_BAR; PG8_MMA(0, 0, At, B0); PG8_MMA(0, 1, At, B1); PG8_BAR; PG8_SCHED;
            PG8_LDA(At, 0, 1); PG8_STAGE(PG8_SB(0, 0), b2, voffB); PG8_STAGE(PG8_SB(0, 1), b2 + hstep, voffB); PG8_STAGE(PG8_SA(0, 0), a2, voffA);
            PG8_WAIT_V(8); PG8_WAIT_L(0); PG8_BAR; PG8_MMA(1, 0, At, B0); PG8_MMA(1, 1, At, B1); PG8_BAR; PG8_SCHED;
            PG8_LDB(B0, 1, 0); PG8_LDB(B1, 1, 1); PG8_SCHED; PG8_LDA(At, 1, 0); PG8_STAGE(PG8_SA(0, 1), a2 + hstep, voffA);
            PG8_WAIT_V(8); PG8_WAIT_L(0); PG8_BAR; PG8_MMA(0, 0, At, B0); PG8_MMA(0, 1, At, B1); PG8_BAR; PG8_SCHED;
            PG8_LDA(At, 1, 1); PG8_STAGE(PG8_SB(1, 0), b3, voffB); PG8_STAGE(PG8_SB(1, 1), b3 + hstep, voffB); PG8_STAGE(PG8_SA(1, 0), a3, voffA);
            PG8_WAIT_V(8); PG8_WAIT_L(0); PG8_BAR; PG8_MMA(1, 0, At, B0); PG8_MMA(1, 1, At, B1); PG8_BAR; PG8_SCHED;
            } else {
            PG8_LDB(B0, 0, 0); PG8_SCHED; PG8_LDA(At, 0, 0); PG8_STAGE(PG8_SA(1, 1), a1 + hstep, voffA);
            PG8_WAIT_L(8); PG8_BAR; PG8_WAIT_L(0); PG8_MMA(0, 0, At, B0); PG8_BAR; PG8_SCHED;
            PG8_LDB(B1, 0, 1); PG8_STAGE(PG8_SB(0, 0), b2, voffB);
            PG8_BAR; PG8_WAIT_L(0); PG8_MMA(0, 1, At, B1); PG8_BAR;
            PG8_LDA(At, 0, 1); PG8_STAGE(PG8_SA(0, 0), a2, voffA);
            PG8_BAR; PG8_WAIT_L(0); PG8_MMA(1, 0, At, B0); PG8_BAR; PG8_SCHED;
            PG8_STAGE(PG8_SB(0, 1), b2 + hstep, voffB);
            PG8_WAIT_V(6); PG8_BAR; PG8_MMA(1, 1, At, B1); PG8_BAR;
            PG8_LDB(B0, 1, 0); PG8_SCHED; PG8_LDA(At, 1, 0); PG8_STAGE(PG8_SA(0, 1), a2 + hstep, voffA);
            PG8_WAIT_L(8); PG8_BAR; PG8_WAIT_L(0); PG8_MMA(0, 0, At, B0); PG8_BAR; PG8_SCHED;
            PG8_LDB(B1, 1, 1); PG8_STAGE(PG8_SB(1, 0), b3, voffB);
            PG8_BAR; PG8_WAIT_L(0); PG8_MMA(0, 1, At, B1); PG8_BAR;
            PG8_LDA(At, 1, 1); PG8_STAGE(PG8_SA(1, 0), a3, voffA);
            PG8_BAR; PG8_WAIT_L(0); PG8_MMA(1, 0, At, B0); PG8_BAR; PG8_SCHED;
            PG8_STAGE(PG8_SB(1, 1), b3 + hstep, voffB);
            PG8_WAIT_V(6); PG8_BAR; PG8_MMA(1, 1, At, B1); PG8_BAR;
            }
        }
        if constexpr (ALIGN_EPI) { if (wr == 0) PG8_BAR; }
        if constexpr (!Epi::AFTER_DRAIN) { E(acc, cur, wr, wc, fr, fq); S.done(cur); } else { if (has_next) E(acc, cur, wr, wc, fr, fq); }
        if (!has_next) break;
#pragma unroll
        for (int a = 0; a < 2; ++a)
#pragma unroll
            for (int b = 0; b < 2; ++b)
#pragma unroll
                for (int m = 0; m < 4; ++m)
#pragma unroll
                    for (int n = 0; n < 2; ++n) acc[a][b][m][n] = (f32x4){0.f, 0.f, 0.f, 0.f};
        cur = nxt; cA = nA; cB = nB; ++ui;
        if constexpr (ALIGN_EPI) { if (wr == 1) PG8_BAR; }
    }
    PG8_WAIT_V(0);
    if constexpr (!ALIGN_EPI) { if (wr == 0) PG8_BAR; }
    PG8_BAR;
    if constexpr (Epi::AFTER_DRAIN) { E.fused(acc, cur, wr, wc, fr, fq, lds, wid, lane); S.done(cur); }
#undef PG8_SA
#undef PG8_SB
#undef PG8_STAGE
#undef PG8_LDA
#undef PG8_LDB
#undef PG8_MMA
#undef PG8_WAIT_V
#undef PG8_WAIT_L
#undef PG8_BAR
#undef PG8_SCHED
}
}

#ifndef MK_ONE_LAUNCH
#define MK_ONE_LAUNCH 1
#endif
constexpr int D = 1024, DFF = 2816, DIN = 1792, DEPTH = 4, SEQ = 8192;
constexpr int MP = 16384, MS = 128, MV = MP + MS, MT = 16640;
constexpr int NGU = 2 * DFF;
constexpr int NMODC = 4 * 9 * D;
constexpr int NBATCH = 130;
constexpr float ALPHA = 1.6817928305074290f;
constexpr float LN_EPS = 1e-5f, RMS_EPS = 1e-6f;
constexpr int NPH = 3 + 10 * DEPTH;
constexpr size_t O_YP = 0, O_YS = 16777216, O_PC = 16908288, O_PP = 16912384, O_PK = 16943104, O_PV = 17074176, O_SC = 17205248, O_SP = 17467392, O_SK = 19433472, O_SV = 27822080;
constexpr size_t WL_BYTES = 40370176;
constexpr size_t WO_GU1 = 0, WO_D1 = 11534336, WO_IN = 17301504, WO_OUT = 20971520, WO_GU2 = 23068672, WO_D2 = 34603008;
constexpr size_t WS_W = 2097152;
constexpr size_t WS_ACC_OLD_UNUSED = 262144;
constexpr size_t CTL_ZERO_BYTES = 262144;
constexpr size_t WS_POOLW = WS_W + 4 * WL_BYTES;
constexpr size_t WS_AC = WS_POOLW + 131072;
constexpr size_t WS_MOD = WS_AC + 524288;
constexpr size_t WS_XB = WS_MOD + (size_t)NBATCH * NMODC * 4;
constexpr size_t WS_YB = WS_XB + (size_t)MT * D * 4;
constexpr size_t WS_HB = WS_YB + (size_t)MT * D * 4;
constexpr size_t WS_HID = WS_HB + (size_t)MT * D * 2;
constexpr size_t WS_PROJ = WS_HID + (size_t)MT * DFF * 2;
constexpr size_t WS_YMIX = WS_PROJ + (size_t)MT * DIN * 2;
constexpr size_t WS_ACC = WS_YMIX + (size_t)MT * D * 2;
constexpr size_t WS_END = WS_ACC + (size_t)22 * MS * D * 4;
static_assert((size_t)NMODC * D * 2 <= (size_t)MT * DFF * 2, "w_ada copy fits the hidden buffer");
static_assert(WS_END < 600000000ull, "workspace");
constexpr int LDS_BYTES = 147456, XB_ST_OFF = LDS_BYTES - 16;
constexpr int NWAVES = 8;

#define LAS __attribute__((address_space(3)))
typedef unsigned short bf16;
typedef unsigned u32x4 __attribute__((ext_vector_type(4)));
typedef unsigned u32x2 __attribute__((ext_vector_type(2)));
typedef float f32x4 __attribute__((ext_vector_type(4)));
typedef short bf16x8 __attribute__((ext_vector_type(8)));

__device__ __forceinline__ unsigned f2bf(float f) { unsigned u = __builtin_bit_cast(unsigned, f); return (u + 0x7fffu + ((u >> 16) & 1u)) >> 16; }
__device__ __forceinline__ unsigned pk2(float lo, float hi) { return f2bf(lo) | (f2bf(hi) << 16); }
__device__ __forceinline__ float bf2f(unsigned short u) { return __builtin_bit_cast(float, (unsigned)u << 16); }
__device__ __forceinline__ float wave_sum(float v) {
#pragma unroll
    for (int o = 1; o < 64; o <<= 1) v += __shfl_xor(v, o);
    return v;
}
__device__ __forceinline__ float wave_max(float v) {
#pragma unroll
    for (int o = 1; o < 64; o <<= 1) v = fmaxf(v, __shfl_xor(v, o));
    return v;
}
__device__ __forceinline__ float silu_f(float g) { return g * __builtin_amdgcn_rcpf(1.0f + __expf(-g)); }
__device__ __forceinline__ int batch_of_row(int r) { return r < SEQ ? 0 : (r < MP ? 1 : (r - MP + 2 < NBATCH ? r - MP + 2 : NBATCH - 1)); }

namespace pg8 {
struct EpiSwiGLU {
    static constexpr bool PERM = true, AFTER_DRAIN = false;
    bf16_t* H;
    __device__ __forceinline__ void operator()(const f32x4 (&acc)[2][2][4][2], const Unit& u, int wr, int wc, int fr, int fq) const {
        const int row0 = u.pm * BM + wr * 64 + fr, col0 = u.pn * 128 + wc * 32 + 8 * fq;
#pragma unroll
        for (int ai = 0; ai < 2; ++ai)
#pragma unroll
            for (int m = 0; m < 4; ++m) {
                bf16_t* rowp = H + (size_t)(row0 + ai * HALF + m * 16) * DFF + col0;
                const f32x4 g0 = acc[ai][0][m][0], g1 = acc[ai][0][m][1], u0 = acc[ai][1][m][0], u1 = acc[ai][1][m][1];
                u32x4 w;
                w.x = cvt_pk_bf16(silu_f(g0[0]) * u0[0], silu_f(g0[1]) * u0[1]); w.y = cvt_pk_bf16(silu_f(g0[2]) * u0[2], silu_f(g0[3]) * u0[3]);
                w.z = cvt_pk_bf16(silu_f(g1[0]) * u1[0], silu_f(g1[1]) * u1[1]); w.w = cvt_pk_bf16(silu_f(g1[2]) * u1[2], silu_f(g1[3]) * u1[3]);
                *(u32x4*)rowp = w;
            }
    }
};
struct MiniOrder {
    StaticOrder base; int c, nmini;
    __host__ __device__ void init(int N, int K, int G_, int c_) { base.init(16384, N, G_, c_); c = c_; nmini = (N / BM) * (K / (2 * BK)); }
    __host__ __device__ bool next(int i, Unit& u) const {
        if (c < nmini) { if (i == 0) { u.pm = 64; u.pn = c & 3; u.k0 = (c >> 2) * 2; u.nk = 2; return true; } --i; }
        return base.next(i, u);
    }
    __device__ __forceinline__ void a_ready(const Unit&) const {}
    __device__ __forceinline__ void done(const Unit&) const {}
};
struct EpiResid {
    static constexpr bool PERM = false, AFTER_DRAIN = false;
    const float* x; float* y; const float* gate; float scale; float* accp;
    __device__ __forceinline__ void operator()(const f32x4 (&acc)[2][2][4][2], const Unit& u, int wr, int wc, int fr, int fq) const {
        const int col0 = u.pn * BM + wc * 32 + 4 * fq;
        if (u.nk) {
#pragma unroll
            for (int m = 0; m < 4; ++m) { float* ap = accp + (size_t)(u.k0 >> 1) * (MS * D) + (size_t)(wr * 64 + m * 16 + fr) * D + col0;
#pragma unroll
                for (int bj = 0; bj < 2; ++bj)
#pragma unroll
                    for (int n = 0; n < 2; ++n) *(f32x4*)(ap + bj * HALF + n * 16) = acc[0][bj][m][n]; }
            return;
        }
#pragma unroll
        for (int ai = 0; ai < 2; ++ai)
#pragma unroll
            for (int m = 0; m < 4; ++m) {
                const int r = u.pm * BM + ai * HALF + wr * 64 + m * 16 + fr;
                const float* gp = gate + (size_t)batch_of_row(r) * NMODC + col0;
                const size_t off = (size_t)r * D + col0;
#pragma unroll
                for (int bj = 0; bj < 2; ++bj)
#pragma unroll
                    for (int n = 0; n < 2; ++n) {
                        const f32x4 xv = *(const f32x4*)(x + off + bj * HALF + n * 16), gv = *(const f32x4*)(gp + bj * HALF + n * 16);
                        *(f32x4*)(y + off + bj * HALF + n * 16) = xv * ALPHA + gv * scale * acc[ai][bj][m][n];
                    }
            }
    }
};
struct EpiMod {
    static constexpr bool PERM = false, AFTER_DRAIN = false;
    float* out; const float* bias;
    __device__ __forceinline__ void operator()(const f32x4 (&acc)[2][2][4][2], const Unit& u, int wr, int wc, int fr, int fq) const {
        const int col0 = u.pn * BM + wc * 32 + 4 * fq;
#pragma unroll
        for (int ai = 0; ai < 2; ++ai)
#pragma unroll
            for (int m = 0; m < 4; ++m) {
                const int r = ai * HALF + wr * 64 + m * 16 + fr;
                if (r < NBATCH) {
#pragma unroll
                    for (int bj = 0; bj < 2; ++bj)
#pragma unroll
                        for (int n = 0; n < 2; ++n) {
                            const int c = col0 + bj * HALF + n * 16;
                            *(f32x4*)(out + (size_t)r * NMODC + c) = acc[ai][bj][m][n] + *(const f32x4*)(bias + c);
                        }
                }
            }
    }
};
}

struct Args { const float* in[25]; float* out; unsigned char* ws; int ph_lo, ph_hi; };
typedef const __attribute__((address_space(4))) Args* kargs_t;
struct Ctx {
    kargs_t ap;
    float* out; unsigned char* ws;
    LAS unsigned char* lds;
    int tid, lane, wave, G, bid;
};
#define IN_XP 0
#define IN_XS 1
#define IN_SCONV 2
#define IN_SPOOL 3
#define IN_CK 4
#define IN_CV 5
#define IN_CP 6
#define IN_CS 7
#define IN_LNG 8
#define IN_LNB 9
#define IN_WADA 10
#define IN_BADA 11
#define IN_F1G 12
#define IN_F1U 13
#define IN_F1D 14
#define IN_WIN 15
#define IN_CONVW 16
#define IN_POOLW 17
#define IN_PSCALE 18
#define IN_SINKS 19
#define IN_MIXG 20
#define IN_WOUT 21
#define IN_F2G 22
#define IN_F2U 23
#define IN_F2D 24

__device__ __forceinline__ void transpose_item(const float* W, int K, int N, bf16* WT, int k0, int n0, int drow0, LAS float* scr, int lane) {
#pragma unroll 8
    for (int i = 0; i < 32; ++i) { const int kk = 2 * i + (lane >> 5); scr[kk * 33 + (lane & 31)] = W[(size_t)(k0 + kk) * N + n0 + (lane & 31)]; }
    asm volatile("s_waitcnt lgkmcnt(0)" ::: "memory");
    const int c = lane & 7;
#pragma unroll
    for (int j = 0; j < 4; ++j) { const int n = (lane >> 3) + 8 * j; const LAS float* s = scr + (8 * c) * 33 + n;
        u32x4 o; o.x = pk2(s[0 * 33], s[1 * 33]); o.y = pk2(s[2 * 33], s[3 * 33]); o.z = pk2(s[4 * 33], s[5 * 33]); o.w = pk2(s[6 * 33], s[7 * 33]);
        *(u32x4*)(WT + (size_t)(drow0 + n) * K + k0 + 8 * c) = o; }
    asm volatile("s_waitcnt lgkmcnt(0)" ::: "memory");
}
constexpr int IT_G = 1408, IT_IN = 896, IT_O = 512, IT_ADA = 4608, IT_LB = 6 * IT_G + IT_IN + IT_O + IT_ADA;
__device__ __forceinline__ void p0_prologue(const Ctx& C) {
    LAS float* scr = (LAS float*)(C.lds + C.wave * 16384);
    const int gw = C.bid * NWAVES + C.wave, NGW = C.G * NWAVES, lane = C.lane;
    unsigned char* ws = C.ws;
    const int NITEMS = DEPTH * IT_LB + 32;
    for (int it = gw; it < NITEMS; it += NGW) {
        const float* W; int K, N, mode = 0; bf16* WT; int r;
        if (it < DEPTH * IT_LB) {
            const int l = it / IT_LB; r = it % IT_LB;
            unsigned char* wl = ws + WS_W + (size_t)l * WL_BYTES;
            const size_t fo = (size_t)l * D * DFF;
            if (r < IT_G) { W = C.ap->in[IN_F1G] + fo; K = D; N = DFF; WT = (bf16*)(wl + WO_GU1); mode = 1; }
            else if ((r -= IT_G) < IT_G) { W = C.ap->in[IN_F1U] + fo; K = D; N = DFF; WT = (bf16*)(wl + WO_GU1); mode = 2; }
            else if ((r -= IT_G) < IT_G) { W = C.ap->in[IN_F1D] + fo; K = DFF; N = D; WT = (bf16*)(wl + WO_D1); }
            else if ((r -= IT_G) < IT_IN) { W = C.ap->in[IN_WIN] + (size_t)l * D * DIN; K = D; N = DIN; WT = (bf16*)(wl + WO_IN); }
            else if ((r -= IT_IN) < IT_O) { W = C.ap->in[IN_WOUT] + (size_t)l * D * D; K = D; N = D; WT = (bf16*)(wl + WO_OUT); }
            else if ((r -= IT_O) < IT_G) { W = C.ap->in[IN_F2G] + fo; K = D; N = DFF; WT = (bf16*)(wl + WO_GU2); mode = 1; }
            else if ((r -= IT_G) < IT_G) { W = C.ap->in[IN_F2U] + fo; K = D; N = DFF; WT = (bf16*)(wl + WO_GU2); mode = 2; }
            else if ((r -= IT_G) < IT_G) { W = C.ap->in[IN_F2D] + fo; K = DFF; N = D; WT = (bf16*)(wl + WO_D2); }
            else { r -= IT_G; W = C.ap->in[IN_WADA] + (size_t)l * D * 9 * D; K = D; N = 9 * D; WT = (bf16*)(ws + WS_HID) + (size_t)l * 9 * D * D; }
        } else {
            r = it - DEPTH * IT_LB; const int mat = r >> 1; r &= 1;
            W = C.ap->in[IN_POOLW] + (size_t)mat * 4096; K = 64; N = 64; WT = (bf16*)(ws + WS_POOLW) + (size_t)mat * 4096;
        }
        const int nblk = N / 32, kb = r / nblk, nb = r % nblk, n0 = 32 * nb;
        const int drow0 = mode == 0 ? n0 : (256 * (n0 >> 7) + (n0 & 127) + (mode == 2 ? 128 : 0));
        transpose_item(W, K, N, WT, 64 * kb, n0, drow0, scr, lane);
    }
    float* XB = (float*)(ws + WS_XB); bf16* HB = (bf16*)(ws + WS_HB); bf16* YM = (bf16*)(ws + WS_YMIX); bf16* AC = (bf16*)(ws + WS_AC);
    for (int j = gw; j < MT + 256; j += NGW) {
        if (j < MT) {
            const float* src = j < MP ? C.ap->in[IN_XP] + (size_t)j * D : (j < MV ? C.ap->in[IN_XS] + (size_t)(j - MP) * D : nullptr);
            f32x4* dst = (f32x4*)(XB + (size_t)j * D) + lane;
#pragma unroll
            for (int q = 0; q < 4; ++q) dst[64 * q] = src ? ((const f32x4*)src)[lane + 64 * q] : (f32x4){0.f, 0.f, 0.f, 0.f};
            if (j >= MV) {
                u32x4* h = (u32x4*)(HB + (size_t)j * D) + lane; u32x4* y = (u32x4*)(YM + (size_t)j * D) + lane;
                h[0] = (u32x4){0, 0, 0, 0}; h[64] = (u32x4){0, 0, 0, 0}; y[0] = (u32x4){0, 0, 0, 0}; y[64] = (u32x4){0, 0, 0, 0};
            }
        } else {
            const int r = j - MT;
            const float* src = r < 2 ? C.ap->in[IN_CP] + (size_t)r * D : (r < NBATCH ? C.ap->in[IN_CS] + (size_t)(r - 2) * D : nullptr);
            u32x2* dst = (u32x2*)(AC + (size_t)r * D) + lane;
#pragma unroll
            for (int q = 0; q < 4; ++q) {
                f32x4 v = src ? ((const f32x4*)src)[lane + 64 * q] : (f32x4){0.f, 0.f, 0.f, 0.f};
                u32x2 o; o.x = pk2(silu_f(v.x), silu_f(v.y)); o.y = pk2(silu_f(v.z), silu_f(v.w)); dst[64 * q] = o;
            }
        }
    }
}

__device__ __forceinline__ void ln_phase(const Ctx& C, const float* src, bool do_ln, const float* lg, const float* lb, float* xdst, bf16* hdst, const float* msh, const float* msc, const float* accp, int nsplit, const float* xres, const float* gate, float scale) {
    const int gw = C.bid * NWAVES + C.wave, NGW = C.G * NWAVES, lane = C.lane;
    for (int r = gw; r < MV; r += NGW) {
        const f32x4* xr = (const f32x4*)(src + (size_t)r * D) + lane;
        f32x4 v[4];
#pragma unroll
        for (int j = 0; j < 4; ++j) v[j] = xr[64 * j];
        if (accp && r >= MP) {
            const f32x4* ar = (const f32x4*)(accp + (size_t)(r - MP) * D) + lane; const f32x4* xx = (const f32x4*)(xres + (size_t)r * D) + lane;
            const f32x4* gr = (const f32x4*)(gate + (size_t)batch_of_row(r) * NMODC) + lane;
            f32x4 a[4] = {ar[0], ar[64], ar[128], ar[192]};
            for (int s = 1; s < nsplit; ++s) { const f32x4* as = ar + (size_t)s * (MS * D / 4);
#pragma unroll
                for (int j = 0; j < 4; ++j) a[j] += as[64 * j]; }
#pragma unroll
            for (int j = 0; j < 4; ++j) v[j] = xx[64 * j] * ALPHA + gr[64 * j] * scale * a[j];
        }
        if (do_ln) {
            float s = 0.f;
#pragma unroll
            for (int j = 0; j < 4; ++j) s += (v[j].x + v[j].y) + (v[j].z + v[j].w);
            const float mean = wave_sum(s) * (1.f / D); float s2 = 0.f;
#pragma unroll
            for (int j = 0; j < 4; ++j) { v[j] = v[j] - mean; s2 += (v[j].x * v[j].x + v[j].y * v[j].y) + (v[j].z * v[j].z + v[j].w * v[j].w); }
            const float rstd = 1.f / sqrtf(wave_sum(s2) * (1.f / D) + LN_EPS);
#pragma unroll
            for (int j = 0; j < 4; ++j) v[j] = v[j] * rstd * ((const f32x4*)lg)[lane + 64 * j] + ((const f32x4*)lb)[lane + 64 * j];
            if (xdst) { f32x4* xo = (f32x4*)(xdst + (size_t)r * D) + lane;
#pragma unroll
                for (int j = 0; j < 4; ++j) xo[64 * j] = v[j]; }
        }
        if (hdst) {
            const size_t mo = (size_t)batch_of_row(r) * NMODC;
            u32x2* ho = (u32x2*)(hdst + (size_t)r * D) + lane;
#pragma unroll
            for (int j = 0; j < 4; ++j) {
                const f32x4 sh = ((const f32x4*)(msh + mo))[lane + 64 * j], sc = ((const f32x4*)(msc + mo))[lane + 64 * j];
                const f32x4 h = v[j] * (sc + 1.0f) + sh;
                u32x2 o; o.x = pk2(h.x, h.y); o.y = pk2(h.z, h.w); ho[64 * j] = o;
            }
        }
    }
}

__device__ __forceinline__ void norm_rows256(LAS float* OUT, bf16* Y, const float* g, int wave, int lane) {
    const f32x4 gg = ((const f32x4*)g)[lane];
#pragma unroll
    for (int i = 0; i < 8; ++i) {
        const int row = wave * 8 + i;
        const f32x4 v = *(const LAS f32x4*)(OUT + row * 260 + lane * 4);
        const float ss = wave_sum((v.x * v.x + v.y * v.y) + (v.z * v.z + v.w * v.w));
        const float sc = 1.0f / sqrtf(ss * (1.f / 256.f) + RMS_EPS);
        u32x2 o; o.x = pk2(v.x * sc * gg.x, v.y * sc * gg.y); o.y = pk2(v.z * sc * gg.z, v.w * sc * gg.w);
        *(u32x2*)(Y + (size_t)row * D + lane * 4) = o;
    }
}

__device__ __forceinline__ void mixer_prompt_tile(const Ctx& C, int l, int tile) {
    const int tid = C.tid, wave = C.wave, lane = C.lane, fr = lane & 15, fq = lane >> 4;
    const int b = tile >> 7, t0 = (tile & 127) * 64;
    const bf16* P = (const bf16*)(C.ws + WS_PROJ) + (size_t)(b * SEQ) * DIN;
    bf16* Y = (bf16*)(C.ws + WS_YMIX) + (size_t)(b * SEQ + t0) * D;
    LAS unsigned char* lds = C.lds;
    LAS float* OUT = (LAS float*)lds;
    LAS bf16* UT = (LAS bf16*)(lds + 66560);
    LAS bf16* PL = (LAS bf16*)(lds + 66560 + 40448);
    const float* mixg = C.ap->in[IN_MIXG] + (size_t)l * D;
    __syncthreads();
    {
        const int c = tid & 255, half = tid >> 8, tb = t0 + half * 32;
        const float* cw = C.ap->in[IN_CONVW] + (size_t)l * 768;
        const float w0 = cw[c], w1 = cw[256 + c], w2 = cw[512 + c];
        float cm2 = 0.f, cm1 = 0.f;
        if (tb >= 2) { const bf16* p2 = P + (size_t)(tb - 2) * DIN; cm2 = bf2f(p2[256 + c]) * bf2f(p2[512 + c]); cm1 = bf2f(p2[DIN + 256 + c]) * bf2f(p2[DIN + 512 + c]); }
        float* pc = C.out + O_PC + (size_t)((l * 2 + b) * 2) * 256;
#pragma unroll 4
        for (int i = 0; i < 32; ++i) {
            const bf16* p = P + (size_t)(tb + i) * DIN;
            const float gb = bf2f(p[c]), cv = bf2f(p[256 + c]) * bf2f(p[512 + c]);
            OUT[(half * 32 + i) * 260 + c] = gb * (w0 * cm2 + w1 * cm1 + w2 * cv);
            if (tb + i >= SEQ - 2) pc[(tb + i - (SEQ - 2)) * 256 + c] = cv;
            cm2 = cm1; cm1 = cv;
        }
    }
    for (int ch = tid; ch < 79 * 32; ch += 512) {
        const int row = ch >> 5, cc = ch & 31, t = t0 - 15 + row;
        u32x4 v = (u32x4){0, 0, 0, 0};
        if (t >= 0) v = *(const u32x4*)(P + (size_t)t * DIN + 768 + cc * 8);
        *(LAS u32x4*)(UT + row * 256 + cc * 8) = v;
    }
    __syncthreads();
    norm_rows256(OUT, Y, mixg, wave, lane);
    {
        const int c = tid & 255, half = tid >> 8, g = c >> 6, w = 2 << g, r0 = 15 + half * 32;
        float s = 0.f;
        for (int j = 1; j < w; ++j) s += bf2f(UT[(r0 - j) * 256 + c]);
        float* pp = C.out + O_PP + (size_t)((l * 2 + b) * 15) * 256;
        for (int i = 0; i < 32; ++i) {
            const float uu = bf2f(UT[(r0 + i) * 256 + c]);
            s += uu;
            const int t = t0 + half * 32 + i;
            const float cnt = (float)(t + 1 < w ? t + 1 : w);
            PL[(half * 32 + i) * 264 + c] = (bf16)f2bf(s / cnt - uu);
            s -= bf2f(UT[(r0 + i - w + 1) * 256 + c]);
            if (t >= SEQ - 15) pp[(t - (SEQ - 15)) * 256 + c] = uu;
        }
    }
    __syncthreads();
    {
        const int g = wave >> 1, dbase = (wave & 1) * 2;
        const bf16* PW = (const bf16*)(C.ws + WS_POOLW) + (size_t)((l * 4 + g) * 64) * 64;
        const float* psc = C.ap->in[IN_PSCALE] + (size_t)l * 256;
        bf16x8 wf[2][2];
#pragma unroll
        for (int di = 0; di < 2; ++di)
#pragma unroll
            for (int kk = 0; kk < 2; ++kk) wf[di][kk] = *(const bf16x8*)(PW + (size_t)(16 * (dbase + di) + fr) * 64 + 32 * kk + 8 * fq);
#pragma unroll
        for (int tb = 0; tb < 4; ++tb) {
            const bf16x8 p0 = *(const LAS bf16x8*)(PL + (16 * tb + fr) * 264 + g * 64 + 8 * fq), p1 = *(const LAS bf16x8*)(PL + (16 * tb + fr) * 264 + g * 64 + 32 + 8 * fq);
#pragma unroll
            for (int di = 0; di < 2; ++di) {
                f32x4 a = (f32x4){0.f, 0.f, 0.f, 0.f};
                a = __builtin_amdgcn_mfma_f32_16x16x32_bf16(wf[di][0], p0, a, 0, 0, 0);
                a = __builtin_amdgcn_mfma_f32_16x16x32_bf16(wf[di][1], p1, a, 0, 0, 0);
                const int col = g * 64 + 16 * (dbase + di) + 4 * fq;
                *(LAS f32x4*)(OUT + (16 * tb + fr) * 260 + col) = a * *(const f32x4*)(psc + col);
            }
        }
    }
    __syncthreads();
    norm_rows256(OUT, Y + 256, mixg + 256, wave, lane);
    __syncthreads();
    {
        const int h = wave, kvh = h >> 2;
        LAS bf16* KS = (LAS bf16*)lds;
        LAS bf16* VT = (LAS bf16*)(lds + 52224);
        LAS float* SSQ = (LAS float*)(lds + 103424);
        for (int ch = tid; ch < 192 * 16; ch += 512) {
            const int key = ch >> 4, dc = ch & 15, t = t0 - 128 + key;
            u32x4 v = (u32x4){0, 0, 0, 0};
            if (t >= 0) v = *(const u32x4*)(P + (size_t)t * DIN + 1536 + dc * 8);
            *(LAS u32x4*)(KS + key * 136 + dc * 8) = v;
        }
        for (int ch = tid; ch < 192 * 16; ch += 512) {
            const int dc = ch / 192, key = ch % 192, t = t0 - 128 + key;
            u32x4 v = (u32x4){0, 0, 0, 0};
            if (t >= 0) v = *(const u32x4*)(P + (size_t)t * DIN + 1664 + dc * 8);
            LAS bf16* vp = VT + (dc * 8) * 200 + key;
            vp[0] = (bf16)(v.x & 0xffffu); vp[200] = (bf16)(v.x >> 16); vp[400] = (bf16)(v.y & 0xffffu); vp[600] = (bf16)(v.y >> 16);
            vp[800] = (bf16)(v.z & 0xffffu); vp[1000] = (bf16)(v.z >> 16); vp[1200] = (bf16)(v.w & 0xffffu); vp[1400] = (bf16)(v.w >> 16);
        }
        bf16x8 qf[4][2];
#pragma unroll
        for (int qb = 0; qb < 4; ++qb)
#pragma unroll
            for (int kk = 0; kk < 2; ++kk) qf[qb][kk] = *(const bf16x8*)(P + (size_t)(t0 + 16 * qb + fr) * DIN + 1024 + h * 64 + 32 * kk + 8 * fq);
        if (t0 >= SEQ - 128) {
            float* pk = C.out + O_PK + (size_t)((l * 2 + b) * 128) * 128; float* pv = C.out + O_PV + (size_t)((l * 2 + b) * 128) * 128;
            for (int idx = tid; idx < 64 * 128; idx += 512) {
                const int row = idx >> 7, col = idx & 127, t = t0 + row;
                pk[(size_t)(t - (SEQ - 128)) * 128 + col] = bf2f(P[(size_t)t * DIN + 1536 + col]);
                pv[(size_t)(t - (SEQ - 128)) * 128 + col] = bf2f(P[(size_t)t * DIN + 1664 + col]);
            }
        }
        __syncthreads();
        const float sink = C.ap->in[IN_SINKS][l * 8 + h];
        const int kmin = 128 - t0;
        f32x4 o[4][4];
#pragma unroll
        for (int qb = 0; qb < 4; ++qb) {
            f32x4 s[12];
#pragma unroll
            for (int kb = 0; kb < 12; ++kb) {
                s[kb] = (f32x4){0.f, 0.f, 0.f, 0.f};
#pragma unroll
                for (int kk = 0; kk < 2; ++kk) {
                    const bf16x8 kf = *(const LAS bf16x8*)(KS + (16 * kb + fr) * 136 + kvh * 64 + 32 * kk + 8 * fq);
                    s[kb] = __builtin_amdgcn_mfma_f32_16x16x32_bf16(kf, qf[qb][kk], s[kb], 0, 0, 0);
                }
            }
            const int qrel = 16 * qb + fr;
            float mx = -1e30f;
#pragma unroll
            for (int kb = 0; kb < 12; ++kb)
#pragma unroll
                for (int j = 0; j < 4; ++j) {
                    const int kidx = 16 * kb + 4 * fq + j;
                    const bool valid = (kidx > qrel) && (kidx <= qrel + 128) && (kidx >= kmin);
                    const float v = valid ? s[kb][j] * 0.125f : -1e30f;
                    s[kb][j] = v; mx = fmaxf(mx, v);
                }
            mx = fmaxf(mx, __shfl_xor(mx, 16)); mx = fmaxf(mx, __shfl_xor(mx, 32)); mx = fmaxf(mx, sink);
            float sum = 0.f;
#pragma unroll
            for (int kb = 0; kb < 12; ++kb)
#pragma unroll
                for (int j = 0; j < 4; ++j) { const float p = __expf(s[kb][j] - mx); s[kb][j] = p; sum += p; }
            sum += __shfl_xor(sum, 16); sum += __shfl_xor(sum, 32);
            const float inv = 1.0f / (sum + __expf(sink - mx));
            bf16x8 pf[6];
#pragma unroll
            for (int c6 = 0; c6 < 6; ++c6) {
                u32x4 w; w.x = pk2(s[2 * c6][0], s[2 * c6][1]); w.y = pk2(s[2 * c6][2], s[2 * c6][3]); w.z = pk2(s[2 * c6 + 1][0], s[2 * c6 + 1][1]); w.w = pk2(s[2 * c6 + 1][2], s[2 * c6 + 1][3]);
                pf[c6] = __builtin_bit_cast(bf16x8, w);
            }
            float ss = 0.f;
#pragma unroll
            for (int db = 0; db < 4; ++db) {
                f32x4 a = (f32x4){0.f, 0.f, 0.f, 0.f};
#pragma unroll
                for (int c6 = 0; c6 < 6; ++c6) {
                    const LAS bf16* vp = VT + (kvh * 64 + 16 * db + fr) * 200 + 32 * c6 + 4 * fq;
                    const u32x2 lo = *(const LAS u32x2*)vp, hi = *(const LAS u32x2*)(vp + 16);
                    u32x4 w; w.x = lo.x; w.y = lo.y; w.z = hi.x; w.w = hi.y;
                    a = __builtin_amdgcn_mfma_f32_16x16x32_bf16(__builtin_bit_cast(bf16x8, w), pf[c6], a, 0, 0, 0);
                }
                a = a * inv; o[qb][db] = a;
                ss += (a.x * a.x + a.y * a.y) + (a.z * a.z + a.w * a.w);
            }
            ss += __shfl_xor(ss, 16); ss += __shfl_xor(ss, 32);
            if (fq == 0) SSQ[h * 64 + 16 * qb + fr] = ss;
        }
        __syncthreads();
        const float* ga = mixg + 512 + h * 64 + 4 * fq;
#pragma unroll
        for (int qb = 0; qb < 4; ++qb) {
            float tot = 0.f;
#pragma unroll
            for (int hh = 0; hh < 8; ++hh) tot += SSQ[hh * 64 + 16 * qb + fr];
            const float sc = 1.0f / sqrtf(tot * (1.f / 512.f) + RMS_EPS);
            bf16* yr = Y + (size_t)(16 * qb + fr) * D + 512 + h * 64 + 4 * fq;
#pragma unroll
            for (int db = 0; db < 4; ++db) {
                const f32x4 gg = *(const f32x4*)(ga + 16 * db), a = o[qb][db];
                u32x2 w; w.x = pk2(a.x * sc * gg.x, a.y * sc * gg.y); w.y = pk2(a.z * sc * gg.z, a.w * sc * gg.w);
                *(u32x2*)(yr + 16 * db) = w;
            }
        }
    }
}

__device__ __forceinline__ void mixer_sample(const Ctx& C, int l, int s) {
    const int tid = C.tid, wave = C.wave, lane = C.lane;
    const bf16* PR = (const bf16*)(C.ws + WS_PROJ) + (size_t)(MP + s) * DIN;
    bf16* Y = (bf16*)(C.ws + WS_YMIX) + (size_t)(MP + s) * D;
    LAS unsigned char* lds = C.lds;
    LAS float* KL = (LAS float*)lds;
    LAS float* VL = (LAS float*)(lds + 66048);
    LAS float* YS = (LAS float*)(lds + 132096);
    LAS float* PLS = (LAS float*)(lds + 136192);
    LAS float* QL = (LAS float*)(lds + 137216);
    LAS float* PB = (LAS float*)(lds + 139264);
    LAS float* WS2 = (LAS float*)(lds + 143360);
    const float* mixg = C.ap->in[IN_MIXG] + (size_t)l * D;
    __syncthreads();
    if (tid < 256) {
        const int c = tid;
        const float gb = bf2f(PR[c]), cv = bf2f(PR[256 + c]) * bf2f(PR[512 + c]);
        const float* sc = C.ap->in[IN_SCONV] + (size_t)((l * MS + s) * 2) * 256;
        const float s0 = sc[c], s1 = sc[256 + c];
        const float* cw = C.ap->in[IN_CONVW] + (size_t)l * 768;
        YS[c] = gb * (cw[c] * s0 + cw[256 + c] * s1 + cw[512 + c] * cv);
        float* oc = C.out + O_SC + (size_t)((l * MS + s) * 2) * 256;
        oc[c] = s1; oc[256 + c] = cv;
    } else {
        const int c = tid - 256, g = c >> 6, w = 2 << g;
        const float uu = bf2f(PR[768 + c]);
        const float* sp = C.ap->in[IN_SPOOL] + (size_t)((l * MS + s) * 15) * 256;
        float* op = C.out + O_SP + (size_t)((l * MS + s) * 15) * 256;
        float sum = uu;
#pragma unroll
        for (int j = 0; j < 15; ++j) {
            const float v = sp[(14 - j) * 256 + c];
            if (j < w - 1) sum += v;
            if (j < 14) op[(13 - j) * 256 + c] = v;
        }
        op[14 * 256 + c] = uu;
        PLS[c] = sum / (float)w - uu;
    }
    QL[tid] = bf2f(PR[1024 + tid]);
    {
        const float* ck = C.ap->in[IN_CK] + (size_t)(l * MS + s) * 16384; const float* cvp = C.ap->in[IN_CV] + (size_t)(l * MS + s) * 16384;
        float* ok = C.out + O_SK + (size_t)(l * MS + s) * 16384; float* ov = C.out + O_SV + (size_t)(l * MS + s) * 16384;
        for (int ch = tid; ch < 128 * 32; ch += 512) {
            const int key = ch >> 5, c4 = (ch & 31) * 4;
            f32x4 kv, vv;
            if (key < 127) { kv = *(const f32x4*)(ck + (size_t)(key + 1) * 128 + c4); vv = *(const f32x4*)(cvp + (size_t)(key + 1) * 128 + c4); }
            else { kv = (f32x4){bf2f(PR[1536 + c4]), bf2f(PR[1536 + c4 + 1]), bf2f(PR[1536 + c4 + 2]), bf2f(PR[1536 + c4 + 3])};
                   vv = (f32x4){bf2f(PR[1664 + c4]), bf2f(PR[1664 + c4 + 1]), bf2f(PR[1664 + c4 + 2]), bf2f(PR[1664 + c4 + 3])}; }
            *(f32x4*)(ok + (size_t)key * 128 + c4) = kv; *(f32x4*)(ov + (size_t)key * 128 + c4) = vv;
            LAS float* kd = KL + key * 129 + c4; LAS float* vd = VL + key * 129 + c4;
            kd[0] = kv.x; kd[1] = kv.y; kd[2] = kv.z; kd[3] = kv.w; vd[0] = vv.x; vd[1] = vv.y; vd[2] = vv.z; vd[3] = vv.w;
        }
    }
    __syncthreads();
    if (tid < 256) {
        const int g = tid >> 6, dd = tid & 63;
        const float* pw = C.ap->in[IN_POOLW] + (size_t)((l * 4 + g) * 64) * 64 + dd;
        float acc = 0.f;
#pragma unroll 8
        for (int c = 0; c < 64; ++c) acc += PLS[g * 64 + c] * pw[c * 64];
        YS[256 + tid] = acc * C.ap->in[IN_PSCALE][l * 256 + tid];
    }
    {
        const int h = wave, kvh = h >> 2;
        const float sink = C.ap->in[IN_SINKS][l * 8 + h];
        float s0 = 0.f, s1 = 0.f;
#pragma unroll 8
        for (int d = 0; d < 64; ++d) { const float q = QL[h * 64 + d]; s0 += q * KL[lane * 129 + kvh * 64 + d]; s1 += q * KL[(lane + 64) * 129 + kvh * 64 + d]; }
        s0 *= 0.125f; s1 *= 0.125f;
        const float mx = fmaxf(wave_max(fmaxf(s0, s1)), sink);
        const float p0 = __expf(s0 - mx), p1 = __expf(s1 - mx);
        const float inv = 1.0f / (wave_sum(p0 + p1) + __expf(sink - mx));
        PB[h * 128 + lane] = p0; PB[h * 128 + 64 + lane] = p1;
        asm volatile("s_waitcnt lgkmcnt(0)" ::: "memory");
        float acc = 0.f;
#pragma unroll 8
        for (int j = 0; j < 128; ++j) acc += PB[h * 128 + j] * VL[j * 129 + kvh * 64 + lane];
        YS[512 + h * 64 + lane] = acc * inv;
    }
    __syncthreads();
    {
        const float v0 = YS[tid], v1 = YS[tid + 512];
        const float a = wave_sum(v0 * v0), bsum = wave_sum(v1 * v1);
        if (lane == 0) { WS2[wave * 2] = a; WS2[wave * 2 + 1] = bsum; }
        __syncthreads();
        float seg = 0.f, seg2 = 0.f;
        const int wlo = tid < 256 ? 0 : 4;
#pragma unroll
        for (int w = 0; w < 4; ++w) seg += WS2[(wlo + w) * 2];
#pragma unroll
        for (int w = 0; w < 8; ++w) seg2 += WS2[w * 2 + 1];
        Y[tid] = (bf16)f2bf(v0 / sqrtf(seg * (1.f / 256.f) + RMS_EPS) * mixg[tid]);
        Y[tid + 512] = (bf16)f2bf(v1 / sqrtf(seg2 * (1.f / 512.f) + RMS_EPS) * mixg[tid + 512]);
    }
}

#define RLX_AGENT __ATOMIC_RELAXED, __HIP_MEMORY_SCOPE_AGENT
#define XB_TMO      128
#define XB_XCNT(j)  (256  + 64 * (j))
#define XB_XSUB(j)  (1280 + 64 * (j))
#define XB_XGEN(j)  (2304 + 64 * (j))
#define XB_TOP      3328
#define XB_TOPGEN   3392
#define XCD_BAR_WORDS 3456
#define XB_SPIN_CAP (1u << 18)

__device__ __forceinline__ unsigned xb_ld(unsigned* p)              { return __hip_atomic_load(p, __ATOMIC_RELAXED, __HIP_MEMORY_SCOPE_AGENT); }
__device__ __forceinline__ unsigned xb_add(unsigned* p, unsigned v) { return __hip_atomic_fetch_add(p, v, __ATOMIC_RELAXED, __HIP_MEMORY_SCOPE_AGENT); }
__device__ __forceinline__ unsigned xb_xcc_id() { return (unsigned)__builtin_amdgcn_s_getreg((3 << 11) | 20) & 0xFu; }
#define XB_SPIN(cond, bar) do { unsigned _sp = 0; while (cond) { __builtin_amdgcn_s_sleep(1); \
    if ((++_sp & 255u) == 0u) { if (xb_ld(&(bar)[XB_TMO])) break; if (_sp > XB_SPIN_CAP) { atomicAdd(&(bar)[XB_TMO], 1u); break; } } } } while (0)

struct XcdBarrier {
    unsigned* bar; unsigned x;
    volatile LAS unsigned* st;
};

__device__ __forceinline__ XcdBarrier xcd_barrier_post(unsigned* bar, volatile LAS unsigned* st) {
    XcdBarrier b; b.bar = bar; b.x = xb_xcc_id(); b.st = st;
    if (threadIdx.x == 0) (void)xb_add(&bar[XB_XCNT(b.x)], 1u);
    return b;
}
__device__ __forceinline__ void xcd_barrier_complete(unsigned* bar, unsigned x, unsigned& nloc, unsigned& nx) {
    const unsigned G = gridDim.x * gridDim.y * gridDim.z;
    unsigned sum, cnt, mine, sp = 0u;
    for (;;) {
        sum = 0u; cnt = 0u; mine = 0u;
#pragma unroll
        for (unsigned j = 0; j < 16; ++j) { const unsigned c = xb_ld(&bar[XB_XCNT(j)]); sum += c; cnt += (c > 0u) ? 1u : 0u; mine = (j == x) ? c : mine; }
        if (sum == G) break;
        __builtin_amdgcn_s_sleep(1);
        if ((++sp & 255u) == 0u) { if (xb_ld(&bar[XB_TMO])) break; if (sp > XB_SPIN_CAP) { atomicAdd(&bar[XB_TMO], 1u); break; } }
    }
    nloc = mine > 0u ? mine : 1u; nx = cnt > 0u ? cnt : 1u;
}

__device__ __forceinline__ void xcd_barrier(const XcdBarrier& b) {
    asm volatile("s_waitcnt vmcnt(0)" ::: "memory");
    __syncthreads();
    if (threadIdx.x == 0) {
        unsigned* bar = b.bar;
        __builtin_amdgcn_s_waitcnt(0);
        unsigned nloc = b.st[0], nx = b.st[1];
        if (nloc == 0u) { xcd_barrier_complete(bar, b.x, nloc, nx); b.st[0] = nloc; b.st[1] = nx; }
        const unsigned old = xb_add(&bar[XB_XSUB(b.x)], 1u);
        const unsigned gen = old / nloc;
        if (old + 1u == (gen + 1u) * nloc) {
            __builtin_amdgcn_fence(__ATOMIC_RELEASE, "agent");
            asm volatile("s_waitcnt vmcnt(0)" ::: "memory");
            const unsigned og = xb_add(&bar[XB_TOP], 1u);
            const unsigned tg = og / nx;
            if (og + 1u == (tg + 1u) * nx) xb_add(&bar[XB_TOPGEN], 1u);
            else XB_SPIN(xb_ld(&bar[XB_TOPGEN]) == tg, bar);
            __builtin_amdgcn_fence(__ATOMIC_ACQUIRE, "agent");
            xb_add(&bar[XB_XGEN(b.x)], 1u);
            asm volatile("s_waitcnt vmcnt(0)" ::: "memory");
        } else {
            XB_SPIN(xb_ld(&bar[XB_XGEN(b.x)]) == gen, bar);
            __builtin_amdgcn_fence(__ATOMIC_ACQUIRE, "agent");
            asm volatile("s_waitcnt vmcnt(0)" ::: "memory");
        }
    }
    __syncthreads();
}

#ifndef PROBE_K
#define PROBE_K -1
#endif
constexpr int PER_L = 10 + ((PROBE_K >= 0 && PROBE_K < 10) ? 1 : 0);
constexpr int NPRE = 3 + (PROBE_K == 100 ? 1 : 0);
constexpr int NSTEP = NPRE + PER_L * DEPTH;
__device__ __forceinline__ int step_phase(int st) {
    if (st < NPRE) return PROBE_K == 100 ? (st == 0 ? 0 : st - 1) : st;
    const int q = st - NPRE, l = q / PER_L, pos = q % PER_L;
    const int k = (PROBE_K >= 0 && PROBE_K < 10 && pos > PROBE_K) ? pos - 1 : pos;
    return 3 + 10 * l + k;
}
__global__ void __launch_bounds__(NWAVES * 64, 2) fwd_kernel(Args args) {
    extern __shared__ __attribute__((aligned(16))) unsigned char lds_raw[];
    cg::grid_group grid = cg::this_grid();
    const int ph_lo = args.ph_lo, ph_hi = args.ph_hi;
    volatile LAS unsigned* bst = (volatile LAS unsigned*)((LAS unsigned char*)lds_raw + XB_ST_OFF);
    if (threadIdx.x < 4) bst[threadIdx.x] = 0u;
    __syncthreads();
    const XcdBarrier xbar = xcd_barrier_post((unsigned*)args.ws, bst);
    for (int st = ph_lo; st < ph_hi; ++st) {
        if (st > ph_lo) { if (st == ph_lo + 1) grid.sync(); else xcd_barrier(xbar); }
        const int ph = step_phase(st);
        kargs_t ap = (kargs_t)__builtin_amdgcn_kernarg_segment_ptr(); asm volatile("" : "+s"(ap));
        int tid = threadIdx.x; asm volatile("" : "+v"(tid));
        Ctx C; C.ap = ap; C.out = ap->out; C.ws = ap->ws; C.lds = (LAS unsigned char*)lds_raw;
        C.tid = tid; C.lane = tid & 63; C.wave = __builtin_amdgcn_readfirstlane(tid >> 6); C.G = gridDim.x; C.bid = blockIdx.x;
        unsigned char* ws = C.ws;
        float* XB = (float*)(ws + WS_XB); float* YB = (float*)(ws + WS_YB); bf16* HB = (bf16*)(ws + WS_HB); bf16* HID = (bf16*)(ws + WS_HID);
        bf16* PROJ = (bf16*)(ws + WS_PROJ); bf16* YMIX = (bf16*)(ws + WS_YMIX); float* MOD = (float*)(ws + WS_MOD);
        if (ph == 0) { p0_prologue(C); continue; }
        if (ph == 1) {
            pg8::Gemm g{(const bf16*)(ws + WS_AC), (const bf16*)(ws + WS_HID), 256, NMODC, D}; pg8::StaticOrder S; S.init(256, NMODC, C.G, C.bid);
            pg8::EpiMod E{MOD, C.ap->in[IN_BADA]};
            pg8::gemm_phase<pg8::EpiMod, pg8::StaticOrder, true, true>(C.lds, g, S, E); continue;
        }
        if (ph == 2) { ln_phase(C, XB, false, nullptr, nullptr, nullptr, HB, MOD + 0 * D, MOD + 1 * D, nullptr, 0, nullptr, nullptr, 0.f); continue; }
        const int l = (ph - 3) / 10, k = (ph - 3) % 10;
        unsigned char* wl = ws + WS_W + (size_t)l * WL_BYTES;
        const float* modl = MOD + (size_t)l * 9 * D;
        if (k == 0 || k == 7) {
            pg8::Gemm g{HB, (const bf16*)(wl + (k == 0 ? WO_GU1 : WO_GU2)), MT, NGU, D}; pg8::StaticOrder S; S.init(MT, NGU, C.G, C.bid);
            pg8::EpiSwiGLU E{HID};
            pg8::gemm_phase<pg8::EpiSwiGLU, pg8::StaticOrder, true, true>(C.lds, g, S, E);
        } else if (k == 1 || k == 8) {
            pg8::Gemm g{HID, (const bf16*)(wl + (k == 1 ? WO_D1 : WO_D2)), MT, D, DFF}; pg8::MiniOrder S; S.init(D, DFF, C.G, C.bid);
            pg8::EpiResid E{XB, YB, modl + (k == 1 ? 2 : 8) * D, 0.5f, (float*)(ws + WS_ACC)};
            pg8::gemm_phase<pg8::EpiResid, pg8::MiniOrder, true, true>(C.lds, g, S, E);
        } else if (k == 5) {
            pg8::Gemm g{YMIX, (const bf16*)(wl + WO_OUT), MT, D, D}; pg8::MiniOrder S; S.init(D, D, C.G, C.bid);
            pg8::EpiResid E{XB, YB, modl + 5 * D, 1.0f, (float*)(ws + WS_ACC)};
            pg8::gemm_phase<pg8::EpiResid, pg8::MiniOrder, true, true>(C.lds, g, S, E);
        } else if (k == 3) {
            pg8::Gemm g{HB, (const bf16*)(wl + WO_IN), MT, DIN, D}; pg8::StaticOrder S; S.init(MT, DIN, C.G, C.bid);
            pg8::EpiBf16<0> E{PROJ, DIN, nullptr, 0, 0, 1.f};
            pg8::gemm_phase<pg8::EpiBf16<0>, pg8::StaticOrder, true, true>(C.lds, g, S, E);
        } else if (k == 4) {
            for (int u = C.bid; u < 256 + MS; u += C.G) { if (u < 256) mixer_prompt_tile(C, l, u); else mixer_sample(C, l, u - 256); }
        } else {
            const int li = k == 2 ? 0 : (k == 6 ? 1 : 2);
            const float* lg = C.ap->in[IN_LNG] + (size_t)(l * 3 + li) * D; const float* lb = C.ap->in[IN_LNB] + (size_t)(l * 3 + li) * D;
            const float* accp = (const float*)(ws + WS_ACC);
            if (k == 2) ln_phase(C, YB, true, lg, lb, XB, HB, modl + 3 * D, modl + 4 * D, accp, 22, XB, modl + 2 * D, 0.5f);
            else if (k == 6) ln_phase(C, YB, true, lg, lb, XB, HB, modl + 6 * D, modl + 7 * D, accp, 8, XB, modl + 5 * D, 1.0f);
            else if (l < DEPTH - 1) ln_phase(C, YB, true, lg, lb, XB, HB, modl + 9 * D, modl + 10 * D, accp, 22, XB, modl + 8 * D, 0.5f);
            else ln_phase(C, YB, true, lg, lb, C.out, nullptr, nullptr, nullptr, accp, 22, XB, modl + 8 * D, 0.5f);
        }
    }
}

extern "C" void kernel_launch(void* const* d_in, const int* in_sizes, int n_in, void* d_out, int out_size, void* d_ws, size_t ws_size, hipStream_t stream) {
    static int grid = 0;
    if (grid == 0) {
        if (n_in != 25 || ws_size < WS_END) { fprintf(stderr, "kernel_launch: need 25 inputs and %zu bytes of workspace; got %d, %zu\n", (size_t)WS_END, n_in, ws_size); grid = -1; return; }
        int dev = 0, cus = 0, per_cu = 0;
        if (hipGetDevice(&dev) != hipSuccess || hipDeviceGetAttribute(&cus, hipDeviceAttributeMultiprocessorCount, dev) != hipSuccess) { grid = -1; return; }
        if (hipFuncSetAttribute((const void*)fwd_kernel, hipFuncAttributeMaxDynamicSharedMemorySize, LDS_BYTES) != hipSuccess) { fprintf(stderr, "kernel_launch: hipFuncSetAttribute failed\n"); grid = -1; return; }
        if (hipOccupancyMaxActiveBlocksPerMultiprocessor(&per_cu, (const void*)fwd_kernel, NWAVES * 64, LDS_BYTES) != hipSuccess || per_cu < 1) { fprintf(stderr, "kernel_launch: occupancy query gave %d\n", per_cu); per_cu = 1; }
        (void)hipGetLastError();
        grid = cus * per_cu;
    }
    if (grid < 0) return;
    if (hipMemsetAsync(d_ws, 0, CTL_ZERO_BYTES, stream) != hipSuccess) { fprintf(stderr, "kernel_launch: memset failed\n"); return; }
    Args a{};
    for (int i = 0; i < 25; ++i) a.in[i] = (const float*)d_in[i];
    a.out = (float*)d_out; a.ws = (unsigned char*)d_ws;
#if MK_ONE_LAUNCH
    a.ph_lo = 0; a.ph_hi = NSTEP;
    void* kargs[] = {&a};
    hipError_t e = hipLaunchCooperativeKernel((const void*)fwd_kernel, dim3(grid), dim3(NWAVES * 64), kargs, LDS_BYTES, stream);
    if (e != hipSuccess) fprintf(stderr, "kernel_launch: cooperative launch failed: %s (grid %d)\n", hipGetErrorString(e), grid);
#else
    for (int ph = 0; ph < NSTEP; ++ph) {
        a.ph_lo = ph; a.ph_hi = ph + 1;
        hipLaunchKernelGGL(fwd_kernel, dim3(grid), dim3(NWAVES * 64), LDS_BYTES, stream, a);
    }
#endif
}
```
